# Optimizing an MI355X kernel written in HIP

```python
import jax, jax.numpy as jnp
from jax import lax
import numpy as np

D_MODEL = 1024
BATCH = 32
SEQ = 2048
DEPTH = 1
DEC_BATCH = 128
DEC_SEQ = 4
PAST_LEN = 8192
PAGE_SIZE = 128

MIX_WIDTH = D_MODEL
HEAD_DIM = 64
N_ATT_HEADS = (MIX_WIDTH // 2) // HEAD_DIM
ATT_WIDTH = N_ATT_HEADS * HEAD_DIM
N_ML_HEADS = 4
ML_WIDTH = MIX_WIDTH - ATT_WIDTH
ML_DK = ML_WIDTH // N_ML_HEADS
ML_DV = ML_DK
DILATED_PATTERNS = ((128, 1), (512, 4), (2048, 16))
MAX_WINDOW = 2048
ROPE_THETA = 10000.0
D_FF = 256 * ((8 * D_MODEL // 3 + 255) // 256)
ML_CHUNK = 128
NORM_EPS = 1e-6
IN_WIDTH = 3 * ATT_WIDTH + 4 * ML_WIDTH + 2 * N_ML_HEADS

kernel_name = "hymba_dilated_swa_mlstm_macaron_step"


def _rmsnorm(x, g):
    xf = x.astype(jnp.float32)
    y = xf * lax.rsqrt(jnp.mean(xf * xf, axis=-1, keepdims=True) + NORM_EPS)
    return (y * g.astype(jnp.float32)).astype(x.dtype)


def _rope(x, pos):
    half = HEAD_DIM // 2
    inv = ROPE_THETA ** (-jnp.arange(half, dtype=jnp.float32) / half)
    ang = pos.astype(jnp.float32)[:, None] * inv[None, :]
    cos = jnp.cos(ang)[None, :, None, :]
    sin = jnp.sin(ang)[None, :, None, :]
    xf = x.astype(jnp.float32)
    x1, x2 = xf[..., :half], xf[..., half:]
    return jnp.concatenate([x1 * cos - x2 * sin, x1 * sin + x2 * cos], axis=-1).astype(x.dtype)


def _swiglu(x, w_gate, w_up, w_down):
    return (jax.nn.silu(x @ w_gate) * (x @ w_up)) @ w_down


def _project(h, pos, w_in, q_gain, k_gain):
    B, T, _ = h.shape
    z = h @ w_in
    widths = (ATT_WIDTH,) * 3 + (ML_WIDTH,) * 4 + (N_ML_HEADS,) * 2
    idx = [sum(widths[:i + 1]) for i in range(len(widths) - 1)]
    aq, ak, av, mq, mk, mv, mo, mi, mf = jnp.split(z, idx, axis=-1)
    aq = _rope(_rmsnorm(aq.reshape(B, T, N_ATT_HEADS, HEAD_DIM), q_gain), pos)
    ak = _rope(_rmsnorm(ak.reshape(B, T, N_ATT_HEADS, HEAD_DIM), k_gain), pos)
    av = av.reshape(B, T, N_ATT_HEADS, HEAD_DIM)
    mq = mq.reshape(B, T, N_ML_HEADS, ML_DK)
    mk = mk.reshape(B, T, N_ML_HEADS, ML_DK) * (ML_DK ** -0.5)
    mv = mv.reshape(B, T, N_ML_HEADS, ML_DV)
    return aq, ak, av, mq, mk, mv, mo, mi, mf


def _merge_by_denominator(outs, lses):
    wts = jax.nn.softmax(jnp.stack(lses, 0), axis=0)
    return jnp.einsum('pbth,pbthd->bthd', wts, jnp.stack(outs, 0))


def _dilated_band_prompt(q, k, v, dil, n_back):
    B, S, H, Dh = q.shape
    L = S // dil
    nb = -(-L // n_back)
    Lp = nb * n_back

    def split(t):
        t = t.reshape(B, L, dil, H, Dh).transpose(0, 2, 1, 3, 4)
        t = jnp.pad(t, ((0, 0), (0, 0), (0, Lp - L), (0, 0), (0, 0)))
        return t.reshape(B, dil, nb, n_back, H, Dh)

    def with_prev(t):
        prev = jnp.pad(t[:, :, :-1], ((0, 0), (0, 0), (1, 0), (0, 0), (0, 0), (0, 0)))
        return jnp.concatenate([prev, t], axis=3)

    qb = split(q)
    kb = with_prev(split(k))
    vb = with_prev(split(v))
    s = jnp.einsum('brnqhd,brnkhd->brnhqk', qb, kb).astype(jnp.float32) * (HEAD_DIM ** -0.5)
    i = jnp.arange(n_back)[:, None]
    j = jnp.arange(2 * n_back)[None, :]
    band = (j >= i) & (j <= i + n_back)
    blk = jnp.arange(nb)[:, None, None]
    valid = band[None] & ((blk > 0) | (j[None] >= n_back))
    s = jnp.where(valid[None, None, :, None], s, -jnp.inf)
    m = jnp.max(s, axis=-1, keepdims=True)
    p = jnp.exp(s - m)
    den = jnp.sum(p, axis=-1, keepdims=True)
    o = jnp.einsum('brnhqk,brnkhd->brnqhd', p / den, vb.astype(jnp.float32))
    lse = (m + jnp.log(den))[..., 0]
    o = o.reshape(B, dil, Lp, H, Dh)[:, :, :L].transpose(0, 2, 1, 3, 4).reshape(B, S, H, Dh)
    lse = lse.transpose(0, 1, 2, 4, 3).reshape(B, dil, Lp, H)[:, :, :L]
    lse = lse.transpose(0, 2, 1, 3).reshape(B, S, H)
    return o, lse


def _dilated_attn_prompt(q, k, v):
    outs, lses = [], []
    for window, dil in DILATED_PATTERNS:
        o, l = _dilated_band_prompt(q, k, v, dil, window // dil)
        outs.append(o)
        lses.append(l)
    return _merge_by_denominator(outs, lses)


def _dilated_attn_sample(q, k_new, v_new, cache_k, cache_v):
    T = q.shape[1]
    Lb = cache_k.shape[1]
    kc = jnp.concatenate([cache_k, k_new.astype(cache_k.dtype)], axis=1)
    vc = jnp.concatenate([cache_v, v_new.astype(cache_v.dtype)], axis=1)
    t = jnp.arange(T)
    outs, lses = [], []
    for window, dil in DILATED_PATTERNS:
        n_back = window // dil
        j = jnp.arange(n_back + 1)
        rows = Lb + t[:, None] - dil * j[None, :]
        valid = rows >= 0
        rows = jnp.maximum(rows, 0)
        kg = kc[:, rows]
        vg = vc[:, rows]
        s = jnp.einsum('bthd,btjhd->bthj', q, kg).astype(jnp.float32) * (HEAD_DIM ** -0.5)
        s = jnp.where(valid[None, :, None, :], s, -jnp.inf)
        m = jnp.max(s, axis=-1, keepdims=True)
        p = jnp.exp(s - m)
        den = jnp.sum(p, axis=-1, keepdims=True)
        outs.append(jnp.einsum('bthj,btjhd->bthd', p / den, vg.astype(jnp.float32)))
        lses.append((m + jnp.log(den))[..., 0])
    return _merge_by_denominator(outs, lses)


def _mlstm_chunk(q, k, v, ig, lf, C, n, m):
    L = q.shape[1]
    b = jnp.cumsum(lf, axis=1).transpose(0, 2, 1)
    igt = ig.transpose(0, 2, 1)
    causal = jnp.tril(jnp.ones((L, L), dtype=bool))
    d = jnp.where(causal, b[..., :, None] - b[..., None, :] + igt[..., None, :], -jnp.inf)
    inter = b + m[..., None]
    m_t = jnp.maximum(jnp.max(d, axis=-1), inter)
    a = jnp.exp(d - m_t[..., None]) * jnp.einsum('bthk,bshk->bhts', q, k)
    w_inter = jnp.exp(inter - m_t)
    num = jnp.einsum('bhts,bshv->bthv', a, v) + jnp.einsum('bht,bthk,bhkv->bthv', w_inter, q, C)
    den = jnp.sum(a, axis=-1) + w_inter * jnp.einsum('bthk,bhk->bht', q, n)
    den = jnp.maximum(jnp.abs(den), jnp.exp(-m_t))
    h = num / den.transpose(0, 2, 1)[..., None]
    b_last = b[..., -1]
    g = b_last[..., None] - b + igt
    m_new = jnp.maximum(b_last + m, jnp.max(g, axis=-1))
    w_s = jnp.exp(g - m_new[..., None])
    w_c = jnp.exp(b_last + m - m_new)
    C_new = w_c[..., None, None] * C + jnp.einsum('bhs,bshk,bshv->bhkv', w_s, k, v)
    n_new = w_c[..., None] * n + jnp.einsum('bhs,bshk->bhk', w_s, k)
    return h, C_new, n_new, m_new


def _mlstm_prompt(q, k, v, ig, lf):
    B, S, H, Dk = q.shape
    ch = min(ML_CHUNK, S)
    nc = S // ch

    def to_chunks(a):
        return a.reshape((B, nc, ch) + a.shape[2:]).swapaxes(0, 1)

    C0 = jnp.zeros((B, H, Dk, ML_DV), jnp.float32)
    n0 = jnp.zeros((B, H, Dk), jnp.float32)
    m0 = jnp.zeros((B, H), jnp.float32)

    def step(carry, xs):
        C, n, m = carry
        h, C, n, m = _mlstm_chunk(*xs, C, n, m)
        return (C, n, m), h

    (C, n, m), hs = lax.scan(step, (C0, n0, m0), tuple(to_chunks(a) for a in (q, k, v, ig, lf)))
    return hs.swapaxes(0, 1).reshape(B, S, H, ML_DV), C, n, m


def _layer(x, pos, p, attn_cache, ml_state):
    B, T, _ = x.shape
    f32 = jnp.float32
    x = x + 0.5 * _swiglu(_rmsnorm(x, p['ffn1_norm']), p['ffn1_w_gate'], p['ffn1_w_up'], p['ffn1_w_down'])
    h = _rmsnorm(x, p['mix_norm'])
    aq, ak, av, mq, mk, mv, mo, mi, mf = _project(h, pos, p['w_in'], p['q_norm'], p['k_norm'])
    ig = mi.astype(f32) + p['b_igate'].astype(f32)
    lf = jax.nn.log_sigmoid(mf.astype(f32) + p['b_fgate'].astype(f32))
    mq, mk, mv = mq.astype(f32), mk.astype(f32), mv.astype(f32)
    if attn_cache is None:
        att = _dilated_attn_prompt(aq, ak, av)
        n_keep = min(MAX_WINDOW, T)
        att_state = (ak[:, T - n_keep:], av[:, T - n_keep:])
        hm, C, n, m = _mlstm_prompt(mq, mk, mv, ig, lf)
    else:
        att = _dilated_attn_sample(aq, ak, av, attn_cache[0], attn_cache[1])
        att_state = (ak, av)
        C0, n0, m0 = ml_state
        hm, C, n, m = _mlstm_chunk(mq, mk, mv, ig, lf, C0.astype(f32), n0.astype(f32), m0.astype(f32))
    hm = _rmsnorm(hm, p['ml_out_norm']) * jax.nn.sigmoid(mo.astype(f32)).reshape(B, T, N_ML_HEADS, ML_DV)
    mix = jnp.concatenate([att.reshape(B, T, ATT_WIDTH).astype(x.dtype),
                           hm.reshape(B, T, ML_WIDTH).astype(x.dtype)], axis=-1)
    x = x + mix @ p['w_out']
    x = x + 0.5 * _swiglu(_rmsnorm(x, p['ffn2_norm']), p['ffn2_w_gate'], p['ffn2_w_up'], p['ffn2_w_down'])
    return x, att_state, (C, n, m)


def setup_inputs(seed: int = 0) -> dict:
    key = jax.random.key(seed)
    ks = jax.random.split(key, 24)
    f32 = jnp.float32

    def nrm(k, shape, scale):
        return jax.random.normal(k, shape, f32) * scale

    def gain(k, shape):
        return 1.0 + 0.02 * jax.random.normal(k, shape, f32)

    win_buf = min(MAX_WINDOW, PAST_LEN)
    return {
        'x_prompt': nrm(ks[0], (BATCH, SEQ, D_MODEL), 1.0),
        'x_sample': nrm(ks[1], (DEC_BATCH, DEC_SEQ, D_MODEL), 1.0),
        'cache_k_win': nrm(ks[2], (DEPTH, DEC_BATCH, win_buf, N_ATT_HEADS, HEAD_DIM), 1.0),
        'cache_v_win': nrm(ks[3], (DEPTH, DEC_BATCH, win_buf, N_ATT_HEADS, HEAD_DIM), 1.0),
        'state_C': nrm(ks[4], (DEPTH, DEC_BATCH, N_ML_HEADS, ML_DK, ML_DV), 0.3),
        'state_n': nrm(ks[5], (DEPTH, DEC_BATCH, N_ML_HEADS, ML_DK), 0.3),
        'state_m': jax.random.uniform(ks[6], (DEPTH, DEC_BATCH, N_ML_HEADS), f32, 0.0, 4.0),
        'ffn1_norm': gain(ks[7], (DEPTH, D_MODEL)),
        'ffn1_w_gate': nrm(ks[8], (DEPTH, D_MODEL, D_FF), D_MODEL ** -0.5),
        'ffn1_w_up': nrm(ks[9], (DEPTH, D_MODEL, D_FF), D_MODEL ** -0.5),
        'ffn1_w_down': nrm(ks[10], (DEPTH, D_FF, D_MODEL), D_FF ** -0.5),
        'mix_norm': gain(ks[11], (DEPTH, D_MODEL)),
        'w_in': nrm(ks[12], (DEPTH, D_MODEL, IN_WIDTH), D_MODEL ** -0.5),
        'q_norm': gain(ks[13], (DEPTH, HEAD_DIM)),
        'k_norm': gain(ks[14], (DEPTH, HEAD_DIM)),
        'b_igate': nrm(ks[15], (DEPTH, N_ML_HEADS), 0.1),
        'b_fgate': jnp.linspace(3.0, 6.0, N_ML_HEADS, dtype=f32)[None, :] + nrm(ks[16], (DEPTH, N_ML_HEADS), 0.1),
        'ml_out_norm': gain(ks[17], (DEPTH, N_ML_HEADS, ML_DV)),
        'w_out': nrm(ks[18], (DEPTH, MIX_WIDTH, D_MODEL), MIX_WIDTH ** -0.5),
        'ffn2_norm': gain(ks[19], (DEPTH, D_MODEL)),
        'ffn2_w_gate': nrm(ks[20], (DEPTH, D_MODEL, D_FF), D_MODEL ** -0.5),
        'ffn2_w_up': nrm(ks[21], (DEPTH, D_MODEL, D_FF), D_MODEL ** -0.5),
        'ffn2_w_down': nrm(ks[22], (DEPTH, D_FF, D_MODEL), D_FF ** -0.5),
    }


def reference(x_prompt, x_sample, cache_k_win, cache_v_win, state_C, state_n, state_m,
              ffn1_norm, ffn1_w_gate, ffn1_w_up, ffn1_w_down, mix_norm, w_in, q_norm, k_norm,
              b_igate, b_fgate, ml_out_norm, w_out, ffn2_norm, ffn2_w_gate, ffn2_w_up, ffn2_w_down):
    pos_p = jnp.arange(x_prompt.shape[1], dtype=jnp.int32)
    pos_s = PAST_LEN + jnp.arange(x_sample.shape[1], dtype=jnp.int32)
    yp, ys = x_prompt, x_sample
    kp_l, vp_l, ks_l, vs_l = [], [], [], []
    Cp_l, np_l, mp_l, Cs_l, ns_l, ms_l = [], [], [], [], [], []
    for l in range(DEPTH):
        p = {
            'ffn1_norm': ffn1_norm[l], 'ffn1_w_gate': ffn1_w_gate[l], 'ffn1_w_up': ffn1_w_up[l],
            'ffn1_w_down': ffn1_w_down[l], 'mix_norm': mix_norm[l], 'w_in': w_in[l],
            'q_norm': q_norm[l], 'k_norm': k_norm[l], 'b_igate': b_igate[l], 'b_fgate': b_fgate[l],
            'ml_out_norm': ml_out_norm[l], 'w_out': w_out[l], 'ffn2_norm': ffn2_norm[l],
            'ffn2_w_gate': ffn2_w_gate[l], 'ffn2_w_up': ffn2_w_up[l], 'ffn2_w_down': ffn2_w_down[l],
        }
        yp, (kp, vp), (Cp, np_, mp) = _layer(yp, pos_p, p, None, None)
        ys, (ks, vs), (Cs, ns, ms) = _layer(ys, pos_s, p, (cache_k_win[l], cache_v_win[l]),
                                            (state_C[l], state_n[l], state_m[l]))
        kp_l.append(kp); vp_l.append(vp); ks_l.append(ks); vs_l.append(vs)
        Cp_l.append(Cp); np_l.append(np_); mp_l.append(mp)
        Cs_l.append(Cs); ns_l.append(ns); ms_l.append(ms)
    return (yp, ys, jnp.stack(kp_l), jnp.stack(vp_l), jnp.stack(ks_l), jnp.stack(vs_l),
            jnp.stack(Cp_l), jnp.stack(np_l), jnp.stack(mp_l),
            jnp.stack(Cs_l), jnp.stack(ns_l), jnp.stack(ms_l))
```

```cpp
#include <hip/hip_runtime.h>
#include <cstdio>
#include <cstdint>

#ifndef MK_N_LAUNCHES
#define MK_N_LAUNCHES 1
#endif

constexpr int D = 1024, SEQ = 2048, NB = 32, MP = NB * SEQ;
constexpr int DECB = 128, DECS = 4, MS = DECB * DECS, MT = MP + MS;
constexpr int FF = 2816, NGU = 2 * FF;
constexpr int NATT = 8, HD = 64, ATTW = 512, NMLH = 4, DK = 128;
constexpr int INW = 3592, INP = 3840;
constexpr int PAST = 8192, WINB = 2048;
constexpr float EPS = 1e-6f;
constexpr float QSCALE = 0.125f * 1.4426950408889634f;
constexpr int NROPE = SEQ + DECS;


__host__ __device__ __forceinline__ size_t att_idx(size_t row, int head) { return row < (size_t)MP ? ((((row >> 11) * 8 + head) << 11) + (row & 2047)) * 64 : row * 512 + (size_t)head * 64; }
__host__ __device__ __forceinline__ size_t ml_idx(size_t row, int head) { return row * 512 + (size_t)head * 128; }

constexpr size_t O_Y = 0;
constexpr size_t O_KP = (size_t)MT * D;
constexpr size_t O_VP = O_KP + (size_t)MP * ATTW;
constexpr size_t O_KS = O_VP + (size_t)MP * ATTW;
constexpr size_t O_VS = O_KS + (size_t)MS * ATTW;
constexpr size_t O_CP = O_VS + (size_t)MS * ATTW;
constexpr size_t O_NP = O_CP + (size_t)NB * NMLH * DK * DK;
constexpr size_t O_MP = O_NP + (size_t)NB * NMLH * DK;
constexpr size_t O_CS = O_MP + (size_t)NB * NMLH;
constexpr size_t O_NS = O_CS + (size_t)DECB * NMLH * DK * DK;
constexpr size_t O_MS = O_NS + (size_t)DECB * NMLH * DK;
constexpr size_t O_END = O_MS + (size_t)DECB * NMLH;
static_assert(O_END == 145834624ull, "d_out map");

constexpr size_t MiB = 1u << 20;
constexpr size_t WS_CTL = 0, CTL_ZERO_BYTES = 1 * MiB;
constexpr size_t WS_WGU1 = 1 * MiB;
constexpr size_t WS_WD1 = WS_WGU1 + (size_t)NGU * D * 2;
constexpr size_t WS_WIN = WS_WD1 + (size_t)D * FF * 2;
constexpr size_t WS_WOUT = WS_WIN + (size_t)INP * D * 2;
constexpr size_t WS_WGU2 = WS_WOUT + (size_t)D * D * 2;
constexpr size_t WS_WD2 = WS_WGU2 + (size_t)NGU * D * 2;
constexpr size_t WS_ROPE = WS_WD2 + (size_t)D * FF * 2;
constexpr size_t WS_XB = 64 * MiB;
constexpr size_t WS_SS = WS_XB + (size_t)MT * D * 2;
constexpr size_t WS_ACT = WS_SS + (size_t)MT * 16 * 4;
constexpr size_t WS_Q = WS_ACT + (size_t)MT * FF * 2;
constexpr size_t SZ_H = (size_t)MT * ATTW * 2;
constexpr size_t WS_K = WS_Q + SZ_H, WS_V = WS_K + SZ_H, WS_MQ = WS_V + SZ_H, WS_MK = WS_MQ + SZ_H, WS_MV = WS_MK + SZ_H, WS_MO = WS_MV + SZ_H;
constexpr size_t WS_G = WS_MO + SZ_H;
constexpr size_t WS_MIX = WS_G + (size_t)MT * 8 * 4;
constexpr size_t WS_OP = WS_MIX + (size_t)MT * D * 2;
constexpr size_t WS_LSE = WS_OP + 2 * (size_t)MP * ATTW * 2;
constexpr size_t WS_CT = WS_LSE + 2 * (size_t)MP * 8 * 4;
constexpr size_t WS_NC = WS_CT + (size_t)128 * 16 * DK * DK * 2;
constexpr size_t WS_MC = WS_NC + (size_t)128 * 16 * DK * 4;
constexpr size_t WS_SLAB = WS_MC + (size_t)128 * 16 * 4;
constexpr size_t WS_RS = WS_SLAB + (size_t)11 * 512 * 1024 * 4;
constexpr size_t WS_X8 = WS_RS + (size_t)MT * 4 + 256;
constexpr size_t WS_END = WS_X8 + (size_t)MT * D;
static_assert(WS_ROPE + (size_t)NROPE * 64 * 4 <= WS_XB, "weights fit below XB");
static_assert(WS_END < 1800 * MiB, "workspace");
static_assert(WS_XB % 256 == 0 && WS_SS % 256 == 0 && WS_ACT % 256 == 0 && WS_Q % 256 == 0 && SZ_H % 256 == 0 && WS_G % 256 == 0 && WS_MIX % 256 == 0 && WS_OP % 256 == 0 && WS_LSE % 256 == 0 && WS_CT % 256 == 0 && WS_NC % 256 == 0 && WS_MC % 256 == 0 && WS_SLAB % 256 == 0 && WS_X8 % 256 == 0, "alignment");

constexpr int CW_Q4 = 64, CW_Q5 = 512;
constexpr int CW_XR = 8192;
constexpr int CW_P0A = 3648;
constexpr int CW_SDONE = 3584;
constexpr int CW_BAR = 4096;

constexpr int NWAVES = 8;
constexpr int RING_BYTES = 131072;
constexpr int MISC_OFF = RING_BYTES + 320;
constexpr int LDSCTL_OFF = RING_BYTES;
constexpr int LDS_BYTES = 147456;

#define GAS __attribute__((address_space(1)))
#define LAS __attribute__((address_space(3)))
namespace pg8 {
#define PG8_LAS __attribute__((address_space(3)))
typedef unsigned short bf16_t;
typedef short bf16x8 __attribute__((ext_vector_type(8)));
typedef float f32x4 __attribute__((ext_vector_type(4)));
typedef unsigned u32x4 __attribute__((ext_vector_type(4)));
typedef int v8i32 __attribute__((ext_vector_type(8)));
typedef double v2d_ __attribute__((ext_vector_type(2)));
constexpr int BM = 256, BK = 64, HALF = 128, HTB = HALF * BK * 2  , STAGE_BYTES = 8 * HTB, NXCD = 8, WGM = 8;

__host__ __device__ __forceinline__ int lds_byte(int r, int c) { const int st = (r >> 4) * 2 + (c >> 5), rr = r & 15, cc = c & 31, ob = rr * 64 + cc * 2; return st * 1024 + (ob ^ (((ob >> 9) & 1) << 5)); }
__host__ __device__ __forceinline__ void stage_rc(int b, int& R, int& C) { const int st = b / 1024, sb = b % 1024, swz = sb ^ (((sb >> 9) & 1) << 5); R = (st >> 1) * 16 + swz / 64; C = (st & 1) * 32 + (swz % 64) / 2; }
__host__ __device__ __forceinline__ int perm32(int rho) { const int n = rho >> 4, i = rho & 15; return 8 * (i >> 2) + 4 * n + (i & 3); }

struct Unit { int pm, pn, k0, nk, slab; };
struct Gemm { const bf16_t* A; const bf16_t* Bt; int M, N, K; };

struct StaticOrder {
    int nM, nN, nwg, G, c, ntk;
    __host__ __device__ void init(int M, int N, int G_, int c_, int K_) { nM = M / BM; nN = N / BM; nwg = nM * nN; G = G_; c = c_; ntk = K_ / BK; }
    __host__ __device__ bool next(int i, Unit& u) const {
        const long L = (long)i * G + c; if (L >= nwg) return false;
        int wgid = (int)L; { const int q = nwg / NXCD, r = nwg % NXCD, xcd = wgid % NXCD, off = wgid / NXCD; wgid = (xcd < r ? xcd * (q + 1) : r * (q + 1) + (xcd - r) * q) + off; }
        const int nig = WGM * nN, gid = wgid / nig, fm = gid * WGM, gsz = (nM - fm) < WGM ? (nM - fm) : WGM;
        u.pm = fm + ((wgid % nig) % gsz); u.pn = (wgid % nig) / gsz; u.k0 = 0; u.nk = ntk; u.slab = -1; return true;
    }
    __device__ __forceinline__ void a_ready(const Unit&) const {}
    __device__ __forceinline__ void done(const Unit&) const {}
};
struct TailSplitOrder {
    StaticOrder P; int nN, nS, nkS, ntk, G, c, nP;
    __host__ __device__ void init(int N, int G_, int c_, int K_, int nkS_) { P.init(65536, N, G_, c_, K_); nN = N / BM; nkS = nkS_; ntk = K_ / BK; nS = ntk / nkS_; G = G_; c = c_; nP = P.nwg; }
    __host__ __device__ bool next(int i, Unit& u) const {
        const long L = (long)i * G + c; if (L < nP) return P.next(i, u);
        const int j = (int)(L - nP); if (j >= 2 * nN * nS) return false;
        const int ks = j % nS, t = j / nS; u.pm = 256 + t / nN; u.pn = t % nN; u.k0 = ks * nkS; u.nk = (ks == nS - 1) ? ntk - ks * nkS : nkS; u.slab = ks; return true;
    }
    __device__ __forceinline__ void a_ready(const Unit&) const {}
    __device__ __forceinline__ void done(const Unit&) const {}
};
struct SameTileOrder {
    int nr, c, ntk;
    __host__ __device__ bool next(int i, Unit& u) const { if (i >= nr) return false; u.pm = c & 7; u.pn = (c >> 3) & 3; u.k0 = 0; u.nk = ntk; u.slab = -1; return true; }
    __device__ __forceinline__ void a_ready(const Unit&) const {}
    __device__ __forceinline__ void done(const Unit&) const {}
};
struct OneUnitOrder {
    int pm, pn, ntk; bool has;
    __host__ __device__ bool next(int i, Unit& u) const { if (i != 0 || !has) return false; u.pm = pm; u.pn = pn; u.k0 = 0; u.nk = ntk; u.slab = -1; return true; }
    __device__ __forceinline__ void a_ready(const Unit&) const {}
    __device__ __forceinline__ void done(const Unit&) const {}
};
struct OffsetOrder {
    StaticOrder P; int n0;
    __host__ __device__ void init(int M, int nn, int n0_, int G_, int c_, int K_, int last_to_ = -1) { P.init(M, nn * BM, G_, c_, K_); n0 = n0_; last_to = last_to_; }
    int last_to;
    __host__ __device__ bool next(int i, Unit& u) const { if (!P.next(i, u)) return false; u.pn = (last_to >= 0 && u.pn == P.nN - 1) ? last_to : u.pn + n0; return true; }
    __device__ __forceinline__ void a_ready(const Unit&) const {}
    __device__ __forceinline__ void done(const Unit&) const {}
};

typedef __bf16 bf16x2_t __attribute__((ext_vector_type(2)));
typedef float f32x2_t __attribute__((ext_vector_type(2)));
__device__ __forceinline__ unsigned pk2(float lo, float hi) { f32x2_t v = {lo, hi}; bf16x2_t b = __builtin_convertvector(v, bf16x2_t); return __builtin_bit_cast(unsigned, b); }
__device__ __forceinline__ u32x4 pk8(f32x4 a, f32x4 b) { u32x4 w; w.x = pk2(a[0], a[1]); w.y = pk2(a[2], a[3]); w.z = pk2(b[0], b[1]); w.w = pk2(b[2], b[3]); return w; }
__device__ __forceinline__ float row_rs(const float* RS, int row) { return RS[row]; }
typedef unsigned u32x2_ __attribute__((ext_vector_type(2)));
__device__ __forceinline__ float clamp_fp8(float x, float scale) { return __builtin_amdgcn_fmed3f(x * scale, -448.f, 448.f); }
__device__ __forceinline__ u32x2_ pk8_fp8(const f32x4 a, const f32x4 b, const float scale) {
    int w0 = 0, w1 = 0;
    w0 = __builtin_amdgcn_cvt_pk_fp8_f32(clamp_fp8(a[0], scale), clamp_fp8(a[1], scale), w0, false); w0 = __builtin_amdgcn_cvt_pk_fp8_f32(clamp_fp8(a[2], scale), clamp_fp8(a[3], scale), w0, true);
    w1 = __builtin_amdgcn_cvt_pk_fp8_f32(clamp_fp8(b[0], scale), clamp_fp8(b[1], scale), w1, false); w1 = __builtin_amdgcn_cvt_pk_fp8_f32(clamp_fp8(b[2], scale), clamp_fp8(b[3], scale), w1, true);
    return (u32x2_){(unsigned)w0, (unsigned)w1};
}
__device__ __forceinline__ float silu_f(float x) { return x * __builtin_amdgcn_rcpf(1.f + __builtin_amdgcn_exp2f(-1.4426950408889634f * x)); }
__device__ __forceinline__ float sigmoid_f(float x) { return __builtin_amdgcn_rcpf(1.f + __builtin_amdgcn_exp2f(-1.4426950408889634f * x)); }

template <bool F8> struct EpiGateUp {
    static constexpr bool PERM = true, AFTER_DRAIN = false;
    bf16_t* ACT; const float* SS; float isc;
    __device__ __forceinline__ void operator()(const f32x4 (&acc)[2][2][4][2], const Unit& u, int wr, int wc, int fr, int fq) const {
        const int row0 = u.pm * BM + wr * 64 + fr, col0 = u.pn * 128 + wc * 32 + 8 * fq;
        float rsv[2][4];
#pragma unroll
        for (int ai = 0; ai < 2; ++ai)
#pragma unroll
            for (int m = 0; m < 4; ++m) rsv[ai][m] = row_rs(SS, row0 + ai * HALF + m * 16) * isc;
#pragma unroll
        for (int ai = 0; ai < 2; ++ai)
#pragma unroll
            for (int m = 0; m < 4; ++m) { const int row = row0 + ai * HALF + m * 16; const float rs = rsv[ai][m]; const float nrs = -1.4426950408889634f * rs, rs2 = rs * rs;
                f32x4 o[2];
#pragma unroll
                for (int n = 0; n < 2; ++n) { const f32x4 t = acc[ai][0][m][n] * nrs, gu = acc[ai][0][m][n] * acc[ai][1][m][n] * rs2;
#pragma unroll
                    for (int i = 0; i < 4; ++i) o[n][i] = gu[i] * __builtin_amdgcn_rcpf(1.f + __builtin_amdgcn_exp2f(t[i])); }
                if (F8) *(u32x2_*)((unsigned char*)ACT + (size_t)row * 2816 + col0) = pk8_fp8(o[0], o[1], 8.f);
                else *(u32x4*)(ACT + (size_t)row * 2816 + col0) = pk8(o[0], o[1]); }
    }
};

template <int MODE> struct EpiResid {
    static constexpr bool PERM = true, AFTER_DRAIN = false;
    const float* resP; const float* resS;
    float* Y; bf16_t* XB; float* SS; float* SLAB; float alpha; unsigned char* X8;
    __device__ __forceinline__ void operator()(const f32x4 (&acc)[2][2][4][2], const Unit& u, int wr, int wc, int fr, int fq) const {
        const int row0 = u.pm * BM + wr * 64 + fr, col0 = u.pn * BM + wc * 32 + 8 * fq;
        const float* const resP_ = resP; const float* const resS_ = resS; float* const Y_ = Y; bf16_t* const XB_ = XB; float* const SS_ = SS; float* const SLAB_ = SLAB; const float alpha_ = alpha; unsigned char* const X8_ = X8;
        const int upm = u.pm, upn = u.pn;
        if (u.slab >= 0) {
#pragma unroll
            for (int ai = 0; ai < 2; ++ai)
#pragma unroll
                for (int m = 0; m < 4; ++m) { bf16_t* sl = (bf16_t*)SLAB_ + ((size_t)u.slab * 512 + (row0 + ai * HALF + m * 16 - 65536)) * 1024 + col0;
#pragma unroll
                    for (int bj = 0; bj < 2; ++bj) *(u32x4*)(sl + bj * HALF) = pk8(acc[ai][bj][m][0], acc[ai][bj][m][1]); }
            return;
        }
        f32x4 nr[2][2];
        auto ldres = [&](int i, f32x4 (&r)[2][2]) { const int row = row0 + (i >> 2) * HALF + (i & 3) * 16;
            const float* rrow = (upm < 256 ? resP_ + (size_t)row * 1024 : resS_ + (size_t)(row - 65536) * 1024);
#pragma unroll
            for (int bj = 0; bj < 2; ++bj) { const int c = col0 + bj * HALF;
                if (MODE == 0) { r[bj][0] = *(const f32x4*)(rrow + c); r[bj][1] = *(const f32x4*)(rrow + c + 4); }
                else { const u32x4 w = *(const u32x4*)(XB_ + (size_t)row * 1024 + c);
                    r[bj][0] = (f32x4){__builtin_bit_cast(float, w.x << 16), __builtin_bit_cast(float, w.x & 0xffff0000u), __builtin_bit_cast(float, w.y << 16), __builtin_bit_cast(float, w.y & 0xffff0000u)};
                    r[bj][1] = (f32x4){__builtin_bit_cast(float, w.z << 16), __builtin_bit_cast(float, w.z & 0xffff0000u), __builtin_bit_cast(float, w.w << 16), __builtin_bit_cast(float, w.w & 0xffff0000u)}; } } };
        ldres(0, nr);
#pragma unroll
        for (int i = 0; i < 8; ++i) { const int ai = i >> 2, m = i & 3; const int row = row0 + ai * HALF + m * 16;
            f32x4 cr[2][2];
#pragma unroll
            for (int bj = 0; bj < 2; ++bj) { cr[bj][0] = nr[bj][0]; cr[bj][1] = nr[bj][1]; }
            if (i < 7) ldres(i + 1, nr);
            asm volatile("" ::: "memory");
            float ss = 0.f;
#pragma unroll
            for (int bj = 0; bj < 2; ++bj) { const int c = col0 + bj * HALF;
                const f32x4 v0 = cr[bj][0] + acc[ai][bj][m][0] * alpha_, v1 = cr[bj][1] + acc[ai][bj][m][1] * alpha_;
                if (MODE == 2) { *(f32x4*)(Y_ + (size_t)row * 1024 + c) = v0; *(f32x4*)(Y_ + (size_t)row * 1024 + c + 4) = v1; }
                else { *(u32x4*)(XB_ + (size_t)row * 1024 + c) = pk8(v0, v1); if (MODE == 1) *(u32x2_*)(X8_ + (size_t)row * 1024 + c) = pk8_fp8(v0, v1, 16.f);
                    ss += (v0[0] * v0[0] + v0[1] * v0[1]) + (v0[2] * v0[2] + v0[3] * v0[3]) + (v1[0] * v1[0] + v1[1] * v1[1]) + (v1[2] * v1[2] + v1[3] * v1[3]); } }
            if (MODE != 2) { ss += __shfl_xor(ss, 16); ss += __shfl_xor(ss, 32); if (fq == 0) SS_[(size_t)row * 16 + upn * 4 + wc] = ss; } }
    }
};

template <int VAR = 0, int RANGE = 0> struct EpiIn {
    static constexpr bool PERM = true, AFTER_DRAIN = false;
    const float* SS; const float* rope; const float* qg; const float* kg; const float* big; const float* bfg;
    bf16_t *Q, *K, *V, *MQ, *MK, *MV, *MO; float* G; float *KoP, *VoP, *KoS, *VoS;
    __device__ __forceinline__ void operator()(const f32x4 (&acc)[2][2][4][2], const Unit& u, int wr, int wc, int fr, int fq) const {
        const int row0 = u.pm * BM + wr * 64 + fr; const int pn = u.pn; const bool samp = u.pm >= 256;
        float rsv[2][4];
#pragma unroll
        for (int ai = 0; ai < 2; ++ai)
#pragma unroll
            for (int m = 0; m < 4; ++m) rsv[ai][m] = row_rs(SS, row0 + ai * HALF + m * 16);
        if ((RANGE == 0 && pn < 4) || RANGE == 1) {
            const bool isK = pn >= 2; const int head = 4 * (pn & 1) + wc; const float* gain = isK ? kg : qg;
            f32x4 glo[2], ghi[2];
#pragma unroll
            for (int n = 0; n < 2; ++n) { glo[n] = *(const f32x4*)(gain + 8 * fq + 4 * n); ghi[n] = *(const f32x4*)(gain + 32 + 8 * fq + 4 * n); }
            f32x4 ncs[2], nsn[2]; float nrsv;
            auto ldrope = [&](int i) { const int row = row0 + (i >> 2) * HALF + (i & 3) * 16; const int prow = samp ? 2048 + ((row - 65536) & 3) : (row & 2047);
                nrsv = row_rs(SS, row);
                const float* rp = rope + (size_t)prow * 64 + 8 * fq;
#pragma unroll
                for (int n = 0; n < 2; ++n) { ncs[n] = *(const f32x4*)(rp + 4 * n); nsn[n] = *(const f32x4*)(rp + 32 + 4 * n); } };
            ldrope(0);
#pragma unroll
            for (int ai = 0; ai < 2; ++ai)
#pragma unroll
                for (int m = 0; m < 4; ++m) { const int row = row0 + ai * HALF + m * 16; const float rs = nrsv;
                    f32x4 v[2][2]; float ss = 0.f;
#pragma unroll
                    for (int bj = 0; bj < 2; ++bj)
#pragma unroll
                        for (int n = 0; n < 2; ++n) { v[bj][n] = acc[ai][bj][m][n] * rs; ss += (v[bj][n][0] * v[bj][n][0] + v[bj][n][1] * v[bj][n][1]) + (v[bj][n][2] * v[bj][n][2] + v[bj][n][3] * v[bj][n][3]); }
                    ss += __shfl_xor(ss, 16); ss += __shfl_xor(ss, 32);
                    const float inv = __builtin_amdgcn_rsqf(ss * (1.f / 64.f) + 1e-6f);
                    f32x4 ccs[2], csn[2];
#pragma unroll
                    for (int n = 0; n < 2; ++n) { ccs[n] = ncs[n]; csn[n] = nsn[n]; }
                    if (ai * 4 + m < 7) ldrope(ai * 4 + m + 1);
                    asm volatile("" ::: "memory");
                    f32x4 o1[2], o2[2];
#pragma unroll
                    for (int n = 0; n < 2; ++n) { const f32x4 cs = ccs[n], sn = csn[n];
                        const f32x4 x1 = v[0][n] * inv * glo[n], x2 = v[1][n] * inv * ghi[n];
                        o1[n] = x1 * cs - x2 * sn; o2[n] = x1 * sn + x2 * cs; }
                    const size_t e = att_idx((size_t)row, head) + 8 * fq;
                    if (VAR == 2) { asm volatile("" :: "v"(o1[0]), "v"(o1[1]), "v"(o2[0]), "v"(o2[1])); }
                    else if (isK) {
                        if (VAR != 1) { float* ko = samp ? KoS + (size_t)(row - 65536) * 512 : KoP + (size_t)row * 512; ko += head * 64 + 8 * fq;
                        *(f32x4*)(ko) = o1[0]; *(f32x4*)(ko + 4) = o1[1]; *(f32x4*)(ko + 32) = o2[0]; *(f32x4*)(ko + 36) = o2[1]; }
                        *(u32x4*)(K + e) = pk8(o1[0], o1[1]); *(u32x4*)(K + e + 32) = pk8(o2[0], o2[1]);
                    } else {
                        *(u32x4*)(Q + e) = pk8(o1[0] * QSCALE, o1[1] * QSCALE); *(u32x4*)(Q + e + 32) = pk8(o2[0] * QSCALE, o2[1] * QSCALE);
                    } }
        } else if ((RANGE == 0 && pn < 14) || RANGE == 2) {
            const int which = (pn - 4) >> 1;
            bf16_t* dst = which == 0 ? V : which == 1 ? MQ : which == 2 ? MK : which == 3 ? MV : MO;
            const float sc = which == 2 ? 0.08838834764831845f : 1.f;
            const int col0 = (pn & 1) * 256 + wc * 32 + 8 * fq;
#pragma unroll
            for (int ai = 0; ai < 2; ++ai)
#pragma unroll
                for (int m = 0; m < 4; ++m) { const int row = row0 + ai * HALF + m * 16; const float rs = rsv[ai][m] * sc;
#pragma unroll
                    for (int bj = 0; bj < 2; ++bj) { f32x4 v0 = acc[ai][bj][m][0] * rs, v1 = acc[ai][bj][m][1] * rs; const int c = col0 + bj * HALF;
                        if (VAR == 2) { asm volatile("" :: "v"(v0), "v"(v1)); continue; }
                        if (which == 0 && VAR != 1) { float* vo = samp ? VoS + (size_t)(row - 65536) * 512 : VoP + (size_t)row * 512; *(f32x4*)(vo + c) = v0; *(f32x4*)(vo + c + 4) = v1; }
                        if (which == 4) {
#pragma unroll
                            for (int i = 0; i < 4; ++i) { v0[i] = sigmoid_f(v0[i]); v1[i] = sigmoid_f(v1[i]); } }
                        *(u32x4*)(dst + (which == 0 ? att_idx((size_t)row, c >> 6) + (c & 63) : ml_idx((size_t)row, c >> 7) + (c & 127))) = pk8(v0, v1); } }
        } else {
            if (wc == 0) {
                const f32x4 bi = *(const f32x4*)big, bf = *(const f32x4*)bfg;
#pragma unroll
                for (int ai = 0; ai < 2; ++ai)
#pragma unroll
                    for (int m = 0; m < 4; ++m) { const int row = row0 + ai * HALF + m * 16; const float rs = rsv[ai][m];
                        const f32x4 ig = acc[ai][0][m][0] * rs + bi; const f32x4 x = acc[ai][0][m][1] * rs + bf; f32x4 lf;
#pragma unroll
                        for (int i = 0; i < 4; ++i) lf[i] = fminf(x[i], 0.f) - 0.6931471805599453f * __builtin_amdgcn_logf(1.f + __builtin_amdgcn_exp2f(-1.4426950408889634f * fabsf(x[i])));
                        if (fq == 0) { *(f32x4*)(G + (size_t)row * 8) = ig; *(f32x4*)(G + (size_t)row * 8 + 4) = lf; } }
            }
        }
    }
};

struct EpiNull {
    static constexpr bool PERM = true, AFTER_DRAIN = false;
    __device__ __forceinline__ void operator()(const f32x4 (&acc)[2][2][4][2], const Unit& u, int wr, int wc, int fr, int fq) const {
#pragma unroll
        for (int ai = 0; ai < 2; ++ai)
#pragma unroll
            for (int bj = 0; bj < 2; ++bj)
#pragma unroll
                for (int m = 0; m < 4; ++m)
#pragma unroll
                    for (int n = 0; n < 2; ++n) asm volatile("" :: "v"(acc[ai][bj][m][n]));
    }
};
template <class Epi, class Sched, bool ALIGN_EPI = false, bool SP2 = false, bool FP8 = false>
__device__ __forceinline__ void gemm_phase(PG8_LAS unsigned char* lds, const Gemm g, const Sched& S, const Epi& E) {
    const int tid = threadIdx.x, wid = __builtin_amdgcn_readfirstlane(tid >> 6), lane = tid & 63, wr = wid >> 2, wc = wid & 3, fr = lane & 15, fq = lane >> 4;
    const int K = g.K;
    const int one_scale = 0x7f7f7f7f;
    unsigned voffA[2], voffB[2];
#pragma unroll
    for (int i = 0; i < 2; ++i) { int R, C; stage_rc(tid * 16 + i * 8192, R, C); const int Rb = Epi::PERM ? ((R & ~31) + perm32(R & 31)) : R;
        voffA[i] = (unsigned)(R * K + C) * 2u; voffB[i] = (unsigned)(Rb * K + C) * 2u; }
    const size_t kstep = (size_t)(BK * 2);
    const size_t hstep = (size_t)HALF * K * 2;
    const size_t tstep = 2 * hstep;
    const unsigned ldsw = (unsigned)wid * 1024u;
    const int aoff = lds_byte(wr * 64 + fr, fq * 8), boff = lds_byte(wc * 32 + fr, fq * 8);
#define PG8_SA(b, h) (((b) * 2 + (h)) * HTB)
#define PG8_SB(b, h) ((4 + (b) * 2 + (h)) * HTB)
    const unsigned ldsb = (unsigned)__builtin_amdgcn_readfirstlane((int)(unsigned)(size_t)lds) + ldsw;
#define PG8_STAGE(bufoff, gbase, voff) do { _Pragma("unroll") for (int _i = 0; _i < 2; ++_i) { \
        const char* gp_ = (const char*)(gbase) + (voff)[_i]; const unsigned ld_ = ldsb + (unsigned)((bufoff) + _i * 8192); unsigned keep_; \
        asm volatile("s_mov_b32 %0, m0\n\ts_mov_b32 m0, %2\n\ts_nop 0\n\tglobal_load_lds_dwordx4 %1, off\n\ts_mov_b32 m0, %0" : "=&s"(keep_) : "v"(gp_), "s"(ld_) : "memory"); } } while (0)
#define PG8_LDA(dst, b, h) do { _Pragma("unroll") for (int m = 0; m < 4; ++m) _Pragma("unroll") for (int k = 0; k < 2; ++k) dst[m][k] = *(const PG8_LAS bf16x8*)(lds + PG8_SA(b, h) + aoff + m * 2048 + k * 1024); } while (0)
#define PG8_LDB(dst, b, h) do { _Pragma("unroll") for (int n = 0; n < 2; ++n) _Pragma("unroll") for (int k = 0; k < 2; ++k) dst[n][k] = *(const PG8_LAS bf16x8*)(lds + PG8_SB(b, h) + boff + n * 2048 + k * 1024); } while (0)
#define PG8_MMA(ai, bj, At, Bt) do { __builtin_amdgcn_s_setprio(1); \
        if constexpr (FP8) { _Pragma("unroll") for (int m = 0; m < 4; ++m) _Pragma("unroll") for (int n = 0; n < 2; ++n) { \
            const v8i32 fa_ = __builtin_bit_cast(v8i32, __builtin_shufflevector(Bt[n][0], Bt[n][1], 0, 1, 2, 3, 4, 5, 6, 7, 8, 9, 10, 11, 12, 13, 14, 15)); \
            const v8i32 fb_ = __builtin_bit_cast(v8i32, __builtin_shufflevector(At[m][0], At[m][1], 0, 1, 2, 3, 4, 5, 6, 7, 8, 9, 10, 11, 12, 13, 14, 15)); \
            asm volatile("s_nop 1\n\tv_mfma_scale_f32_16x16x128_f8f6f4 %0, %1, %2, %0, %3, %3 op_sel_hi:[0,0,0]" : "+v"(acc[ai][bj][m][n]) : "v"(fa_), "v"(fb_), "v"(one_scale)); } } \
        else { _Pragma("unroll") for (int m = 0; m < 4; ++m) _Pragma("unroll") for (int n = 0; n < 2; ++n) _Pragma("unroll") for (int k = 0; k < 2; ++k) \
            acc[ai][bj][m][n] = __builtin_amdgcn_mfma_f32_16x16x32_bf16(Bt[n][k], At[m][k], acc[ai][bj][m][n], 0, 0, 0); } \
        __builtin_amdgcn_s_setprio(0); } while (0)
#define PG8_WAIT_V(n) asm volatile("s_waitcnt vmcnt(" #n ")" ::: "memory")
#define PG8_WAIT_L(n) asm volatile("s_waitcnt lgkmcnt(" #n ")" ::: "memory")
#define PG8_BAR __builtin_amdgcn_s_barrier()
#define PG8_SCHED __builtin_amdgcn_sched_barrier(0)
    Unit cur, nxt; int ui = 0;
    if (!S.next(0, cur)) return;
    f32x4 acc[2][2][4][2];
#pragma unroll
    for (int a = 0; a < 2; ++a)
#pragma unroll
        for (int b = 0; b < 2; ++b)
#pragma unroll
            for (int m = 0; m < 4; ++m)
#pragma unroll
                for (int n = 0; n < 2; ++n) { double z0_, z1_; asm volatile("v_mov_b64 %0, 0\n\tv_mov_b64 %1, 0" : "=v"(z0_), "=v"(z1_));
                    const v2d_ zz_ = {z0_, z1_}; acc[a][b][m][n] = __builtin_bit_cast(f32x4, zz_); }
    bf16x8 At[4][2], B0[2][2], B1[2][2];
    const char* cA = (const char*)g.A + (size_t)cur.pm * tstep + (size_t)cur.k0 * kstep; const char* cB = (const char*)g.Bt + (size_t)cur.pn * tstep + (size_t)cur.k0 * kstep;
    S.a_ready(cur);
    if constexpr (SP2) {
        PG8_STAGE(PG8_SB(0, 0), cB, voffB); PG8_STAGE(PG8_SB(0, 1), cB + hstep, voffB); PG8_STAGE(PG8_SA(0, 0), cA, voffA); PG8_STAGE(PG8_SA(0, 1), cA + hstep, voffA);
        if (wr == 1) PG8_BAR;
        PG8_WAIT_V(2); PG8_BAR;
        PG8_STAGE(PG8_SB(1, 0), cB + kstep, voffB); PG8_STAGE(PG8_SA(1, 0), cA + kstep, voffA); PG8_STAGE(PG8_SB(1, 1), cB + hstep + kstep, voffB);
        PG8_WAIT_V(6); PG8_BAR;
    } else {
        PG8_STAGE(PG8_SB(0, 0), cB, voffB); PG8_STAGE(PG8_SA(0, 0), cA, voffA); PG8_STAGE(PG8_SB(0, 1), cB + hstep, voffB); PG8_STAGE(PG8_SA(0, 1), cA + hstep, voffA);
        if (wr == 1) PG8_BAR;
        PG8_WAIT_V(4); PG8_BAR;
        PG8_STAGE(PG8_SB(1, 0), cB + kstep, voffB); PG8_STAGE(PG8_SA(1, 0), cA + kstep, voffA); PG8_STAGE(PG8_SB(1, 1), cB + hstep + kstep, voffB);
        PG8_WAIT_V(6); PG8_BAR;
    }
    for (;;) {
        const bool has_next = S.next(ui + 1, nxt);
        const char* nA = has_next ? (const char*)g.A + (size_t)nxt.pm * tstep + (size_t)nxt.k0 * kstep : cA; const char* nB = has_next ? (const char*)g.Bt + (size_t)nxt.pn * tstep + (size_t)nxt.k0 * kstep : cB;
        const int nt = cur.nk;
        for (int t = 0; t < nt; t += 2) {
            const bool last = (t == nt - 2);
            const char* a1 = cA + (size_t)(t + 1) * kstep;
            const char* a2 = last ? nA : cA + (size_t)(t + 2) * kstep; const char* b2 = last ? nB : cB + (size_t)(t + 2) * kstep;
            const char* a3 = a2 + kstep; const char* b3 = b2 + kstep;
            if (last && has_next) S.a_ready(nxt);
            if constexpr (SP2) {
            PG8_LDB(B0, 0, 0); PG8_LDB(B1, 0, 1); PG8_SCHED; PG8_LDA(At, 0, 0); PG8_STAGE(PG8_SA(1, 1), a1 + hstep, voffA);
            PG8_WAIT_V(8); PG8_WAIT_L(0); PG8_BAR; PG8_MMA(0, 0, At, B0); PG8_MMA(0, 1, At, B1); PG8_BAR; PG8_SCHED;
            PG8_LDA(At, 0, 1); PG8_STAGE(PG8_SB(0, 0), b2, voffB); PG8_STAGE(PG8_SB(0, 1), b2 + hstep, voffB); PG8_STAGE(PG8_SA(0, 0), a2, voffA);
            PG8_WAIT_V(8); PG8_WAIT_L(0); PG8_BAR; PG8_MMA(1, 0, At, B0); PG8_MMA(1, 1, At, B1); PG8_BAR; PG8_SCHED;
            PG8_LDB(B0, 1, 0); PG8_LDB(B1, 1, 1); PG8_SCHED; PG8_LDA(At, 1, 0); PG8_STAGE(PG8_SA(0, 1), a2 + hstep, voffA);
            PG8_WAIT_V(8); PG8_WAIT_L(0); PG8_BAR; PG8_MMA(0, 0, At, B0); PG8_MMA(0, 1, At, B1); PG8_BAR; PG8_SCHED;
            PG8_LDA(At, 1, 1); PG8_STAGE(PG8_SB(1, 0), b3, voffB); PG8_STAGE(PG8_SB(1, 1), b3 + hstep, voffB); PG8_STAGE(PG8_SA(1, 0), a3, voffA);
            PG8_WAIT_V(8); PG8_WAIT_L(0); PG8_BAR; PG8_MMA(1, 0, At, B0); PG8_MMA(1, 1, At, B1); PG8_BAR; PG8_SCHED;
            } else {
            PG8_LDB(B0, 0, 0); PG8_SCHED; PG8_LDA(At, 0, 0); PG8_STAGE(PG8_SA(1, 1), a1 + hstep, voffA);
            PG8_WAIT_L(8); PG8_BAR; PG8_WAIT_L(0); PG8_MMA(0, 0, At, B0); PG8_BAR; PG8_SCHED;
            PG8_LDB(B1, 0, 1); PG8_STAGE(PG8_SB(0, 0), b2, voffB);
            PG8_BAR; PG8_WAIT_L(0); PG8_MMA(0, 1, At, B1); PG8_BAR;
            PG8_LDA(At, 0, 1); PG8_STAGE(PG8_SA(0, 0), a2, voffA);
            PG8_BAR; PG8_WAIT_L(0); PG8_MMA(1, 0, At, B0); PG8_BAR; PG8_SCHED;
            PG8_STAGE(PG8_SB(0, 1), b2 + hstep, voffB);
            PG8_WAIT_V(6); PG8_BAR; PG8_MMA(1, 1, At, B1); PG8_BAR;
            PG8_LDB(B0, 1, 0); PG8_SCHED; PG8_LDA(At, 1, 0); PG8_STAGE(PG8_SA(0, 1), a2 + hstep, voffA);
            PG8_WAIT_L(8); PG8_BAR; PG8_WAIT_L(0); PG8_MMA(0, 0, At, B0); PG8_BAR; PG8_SCHED;
            PG8_LDB(B1, 1, 1); PG8_STAGE(PG8_SB(1, 0), b3, voffB);
            PG8_BAR; PG8_WAIT_L(0); PG8_MMA(0, 1, At, B1); PG8_BAR;
            PG8_LDA(At, 1, 1); PG8_STAGE(PG8_SA(1, 0), a3, voffA);
            PG8_BAR; PG8_WAIT_L(0); PG8_MMA(1, 0, At, B0); PG8_BAR; PG8_SCHED;
            PG8_STAGE(PG8_SB(1, 1), b3 + hstep, voffB);
            PG8_WAIT_V(6); PG8_BAR; PG8_MMA(1, 1, At, B1); PG8_BAR;
            }
        }
        if constexpr (ALIGN_EPI) { if (wr == 0) PG8_BAR; }
        if constexpr (FP8) asm volatile("s_nop 7\n\ts_nop 7\n\ts_nop 7" ::: "memory");
        if constexpr (!Epi::AFTER_DRAIN) { E(acc, cur, wr, wc, fr, fq); S.done(cur); }
        if (!has_next) break;
#pragma unroll
        for (int a = 0; a < 2; ++a)
#pragma unroll
            for (int b = 0; b < 2; ++b)
#pragma unroll
                for (int m = 0; m < 4; ++m)
#pragma unroll
                    for (int n = 0; n < 2; ++n) { double z0_, z1_; asm volatile("v_mov_b64 %0, 0\n\tv_mov_b64 %1, 0" : "=v"(z0_), "=v"(z1_));
                    const v2d_ zz_ = {z0_, z1_}; acc[a][b][m][n] = __builtin_bit_cast(f32x4, zz_); }
        cur = nxt; cA = nA; cB = nB; ++ui;
        if constexpr (ALIGN_EPI) { if (wr == 1) PG8_BAR; }
    }
    PG8_WAIT_V(0);
    if constexpr (!ALIGN_EPI) { if (wr == 0) PG8_BAR; }
    PG8_BAR;
    if constexpr (Epi::AFTER_DRAIN) { E.fused(acc, cur, wr, wc, fr, fq, lds, wid, lane); S.done(cur); }
#undef PG8_SA
#undef PG8_SB
#undef PG8_STAGE
#undef PG8_LDA
#undef PG8_LDB
#undef PG8_MMA
#undef PG8_WAIT_V
#undef PG8_WAIT_L
#undef PG8_BAR
#undef PG8_SCHED
}
}

typedef unsigned short bf16;
typedef unsigned v4u __attribute__((ext_vector_type(4)));
typedef unsigned v2u __attribute__((ext_vector_type(2)));
typedef float f32x4 __attribute__((ext_vector_type(4)));
typedef short bf16x8 __attribute__((ext_vector_type(8)));
typedef short s16x4 __attribute__((ext_vector_type(4)));
typedef short v4i16_t __attribute__((ext_vector_type(4)));
typedef GAS unsigned gu32;
#define RLX_AGENT __ATOMIC_RELAXED, __HIP_MEMORY_SCOPE_AGENT
using pg8::pk2;
__device__ __forceinline__ float bf2f(unsigned short h) { return __builtin_bit_cast(float, (unsigned)h << 16); }
__device__ __forceinline__ float bflo(unsigned w) { return __builtin_bit_cast(float, w << 16); }
__device__ __forceinline__ float bfhi(unsigned w) { return __builtin_bit_cast(float, w & 0xffff0000u); }
__device__ __forceinline__ f32x4 mfma16(bf16x8 a, bf16x8 b, f32x4 c) { return __builtin_amdgcn_mfma_f32_16x16x32_bf16(a, b, c, 0, 0, 0); }
__device__ __forceinline__ s16x4 ds_tr(const LAS unsigned char* p) { return __builtin_bit_cast(s16x4, __builtin_amdgcn_ds_read_tr16_b64_v4i16((LAS v4i16_t*)p)); }
__device__ __forceinline__ bf16x8 cat4(s16x4 a, s16x4 b) { bf16x8 r; r[0] = a[0]; r[1] = a[1]; r[2] = a[2]; r[3] = a[3]; r[4] = b[0]; r[5] = b[1]; r[6] = b[2]; r[7] = b[3]; return r; }
__device__ __forceinline__ bf16x8 pack8f(f32x4 a, f32x4 b) { v4u w; w.x = pk2(a[0], a[1]); w.y = pk2(a[2], a[3]); w.z = pk2(b[0], b[1]); w.w = pk2(b[2], b[3]); return __builtin_bit_cast(bf16x8, w); }
__device__ __forceinline__ float wave_sum(float v) {
#pragma unroll
    for (int o = 1; o < 64; o <<= 1) v += __shfl_xor(v, o);
    return v;
}
__device__ __forceinline__ float wave_max(float v) {
#pragma unroll
    for (int o = 1; o < 64; o <<= 1) v = fmaxf(v, __shfl_xor(v, o));
    return v;
}


__device__ __forceinline__ void st16_pair(bf16* rowp, int t0, int t1, v2u wa, v2u wb, int g) {
    const auto s0 = __builtin_amdgcn_permlane16_swap(wa.x, wb.x, false, false); const auto s1 = __builtin_amdgcn_permlane16_swap(wa.y, wb.y, false, false);
    v4u o; o.x = s0[0]; o.y = s1[0]; o.z = s0[1]; o.w = s1[1];
    *(GAS v4u*)(rowp + 16 * ((g & 1) ? t1 : t0) + 8 * (g >> 1)) = o;
}
__device__ __forceinline__ v4u ld16_raw(const bf16* rowp, int t0, int t1, int g) { return *(const GAS v4u*)(rowp + 16 * ((g & 1) ? t1 : t0) + 8 * (g >> 1)); }
__device__ __forceinline__ void ul16_pair(v4u i, v2u& wa, v2u& wb) {
    const auto s0 = __builtin_amdgcn_permlane16_swap(i.x, i.z, false, false); const auto s1 = __builtin_amdgcn_permlane16_swap(i.y, i.w, false, false);
    wa.x = s0[0]; wb.x = s0[1]; wa.y = s1[0]; wb.y = s1[1];
}
__device__ __forceinline__ void ld16_pair(const bf16* rowp, int t0, int t1, v2u& wa, v2u& wb, int g) {
    const v4u i = *(const GAS v4u*)(rowp + 16 * ((g & 1) ? t1 : t0) + 8 * (g >> 1));
    const auto s0 = __builtin_amdgcn_permlane16_swap(i.x, i.z, false, false); const auto s1 = __builtin_amdgcn_permlane16_swap(i.y, i.w, false, false);
    wa.x = s0[0]; wb.x = s0[1]; wa.y = s1[0]; wb.y = s1[1];
}

#define XB_TMO      128
#define XB_XCNT(j)  (256  + 64 * (j))
#define XB_XSUB(j)  (1280 + 64 * (j))
#define XB_XGEN(j)  (2304 + 64 * (j))
#define XB_TOP      3328
#define XB_TOPGEN   3392
#define XCD_BAR_WORDS 3456
#define XB_SPIN_CAP (1u << 18)

__device__ __forceinline__ unsigned xb_ld(unsigned* p)              { return __hip_atomic_load(p, __ATOMIC_RELAXED, __HIP_MEMORY_SCOPE_AGENT); }
__device__ __forceinline__ unsigned xb_add(unsigned* p, unsigned v) { return __hip_atomic_fetch_add(p, v, __ATOMIC_RELAXED, __HIP_MEMORY_SCOPE_AGENT); }
__device__ __forceinline__ unsigned xb_xcc_id() { return (unsigned)__builtin_amdgcn_s_getreg((3 << 11) | 20) & 0xFu; }
#define XB_SPIN(cond, bar) do { unsigned _sp = 0; while (cond) { __builtin_amdgcn_s_sleep(1); \
    if ((++_sp & 255u) == 0u) { if (xb_ld(&(bar)[XB_TMO])) break; if (_sp > XB_SPIN_CAP) { atomicAdd(&(bar)[XB_TMO], 1u); break; } } } } while (0)

struct XcdBarrier {
    unsigned* bar; unsigned x;
    volatile LAS unsigned* st;
};
__device__ __forceinline__ XcdBarrier xcd_barrier_post(unsigned* bar, volatile LAS unsigned* st) {
    XcdBarrier b; b.bar = bar; b.x = xb_xcc_id(); b.st = st;
    if (threadIdx.x == 0) (void)xb_add(&bar[XB_XCNT(b.x)], 1u);
    return b;
}
__device__ __forceinline__ void xcd_barrier_complete(unsigned* bar, unsigned x, unsigned& nloc, unsigned& nx) {
    const unsigned G = gridDim.x * gridDim.y * gridDim.z;
    unsigned sum, cnt, mine, sp = 0u;
    for (;;) {
        sum = 0u; cnt = 0u; mine = 0u;
#pragma unroll
        for (unsigned j = 0; j < 16; ++j) { const unsigned c = xb_ld(&bar[XB_XCNT(j)]); sum += c; cnt += (c > 0u) ? 1u : 0u; mine = (j == x) ? c : mine; }
        if (sum == G) break;
        __builtin_amdgcn_s_sleep(1);
        if ((++sp & 255u) == 0u) { if (xb_ld(&bar[XB_TMO])) break; if (sp > XB_SPIN_CAP) { atomicAdd(&bar[XB_TMO], 1u); break; } }
    }
    nloc = mine > 0u ? mine : 1u; nx = cnt > 0u ? cnt : 1u;
}
__device__ __forceinline__ void xcd_barrier(const XcdBarrier& b) {
    __builtin_amdgcn_s_waitcnt(0x0F70);
    asm volatile("" ::: "memory");
    __syncthreads();
    if (threadIdx.x == 0) {
        unsigned* bar = b.bar;
        __builtin_amdgcn_s_waitcnt(0);
        unsigned nloc = b.st[0], nx = b.st[1];
        if (nloc == 0u) { xcd_barrier_complete(bar, b.x, nloc, nx); b.st[0] = nloc; b.st[1] = nx; }
        const unsigned old = xb_add(&bar[XB_XSUB(b.x)], 1u);
        const unsigned gen = old / nloc;
        if (old + 1u == (gen + 1u) * nloc) {
            __builtin_amdgcn_fence(__ATOMIC_RELEASE, "agent");
            asm volatile("s_waitcnt vmcnt(0)" ::: "memory");
            const unsigned og = xb_add(&bar[XB_TOP], 1u);
            const unsigned tg = og / nx;
            if (og + 1u == (tg + 1u) * nx) xb_add(&bar[XB_TOPGEN], 1u);
            else XB_SPIN(xb_ld(&bar[XB_TOPGEN]) == tg, bar);
            __builtin_amdgcn_fence(__ATOMIC_ACQUIRE, "agent");
            xb_add(&bar[XB_XGEN(b.x)], 1u);
            asm volatile("s_waitcnt vmcnt(0)" ::: "memory");
        } else {
            XB_SPIN(xb_ld(&bar[XB_XGEN(b.x)]) == gen, bar);
            __builtin_amdgcn_fence(__ATOMIC_ACQUIRE, "agent");
            asm volatile("s_waitcnt vmcnt(0)" ::: "memory");
        }
    }
    __syncthreads();
}

struct Frame {
    LAS unsigned char* lds;
    volatile LAS unsigned* MISC;
    gu32* ctl;
    int tid, lane, wave, G;
    const float* in[23];
    float* out;
    unsigned char* ws;
};
#define WSP(T, off) ((T*)(F.ws + (off)))

template <bool FP8 = false>
__device__ __forceinline__ void p0_item(const float* W, int ldw, int scol0, int nvalid, const float* gain, bf16* Bt, int K, int drow0, int k0, LAS float* scr, int lane, float f8s = 64.f) {
    float wv_[32];
#pragma unroll
    for (int i = 0; i < 32; ++i) { const int kk = 2 * i + (lane >> 5), j = lane & 31; wv_[i] = (j < nvalid) ? W[(size_t)(k0 + kk) * ldw + scol0 + j] : 0.f; }
    const float gl_ = gain ? gain[k0 + lane] : 1.f;
#pragma unroll
    for (int i = 0; i < 32; ++i) { const int kk = 2 * i + (lane >> 5), j = lane & 31; scr[kk * 33 + j] = wv_[i] * __shfl(gl_, kk); }
    asm volatile("s_waitcnt lgkmcnt(0)" ::: "memory");
    const int c = lane & 7;
#pragma unroll
    for (int jj = 0; jj < 4; ++jj) { const int n = (lane >> 3) + 8 * jj; const LAS float* s = scr + (8 * c) * 33 + n;
        if (FP8) {
            int w0 = 0, w1 = 0;
            w0 = __builtin_amdgcn_cvt_pk_fp8_f32(s[0 * 33] * f8s, s[1 * 33] * f8s, w0, false); w0 = __builtin_amdgcn_cvt_pk_fp8_f32(s[2 * 33] * f8s, s[3 * 33] * f8s, w0, true);
            w1 = __builtin_amdgcn_cvt_pk_fp8_f32(s[4 * 33] * f8s, s[5 * 33] * f8s, w1, false); w1 = __builtin_amdgcn_cvt_pk_fp8_f32(s[6 * 33] * f8s, s[7 * 33] * f8s, w1, true);
            *(GAS v2u*)((unsigned char*)Bt + (size_t)(drow0 + n) * K + k0 + 8 * c) = (v2u){(unsigned)w0, (unsigned)w1};
        } else {
        v4u o; o.x = pk2(s[0 * 33], s[1 * 33]); o.y = pk2(s[2 * 33], s[3 * 33]); o.z = pk2(s[4 * 33], s[5 * 33]); o.w = pk2(s[6 * 33], s[7 * 33]);
        *(GAS v4u*)(Bt + (size_t)(drow0 + n) * K + k0 + 8 * c) = o; } }
    asm volatile("s_waitcnt lgkmcnt(0)" ::: "memory");
}
__device__ __forceinline__ void p0_rows(Frame& F, int lo, int hi, int gw, int NGW) {
    const int lane = F.lane;
    bf16* XB = WSP(bf16, WS_XB); float* RS = WSP(float, WS_RS);
    const float *xp = F.in[0], *xs = F.in[1]; asm volatile("" : "+s"(xp), "+s"(xs));
    constexpr int RPT = 4;
    f32x4 nv[RPT][4];
    auto ldrows = [&](int m0) {
#pragma unroll
        for (int q = 0; q < RPT; ++q) { const int m = m0 + q; const float* xrow = m < MP ? xp + (size_t)m * D : xs + (size_t)(m - MP) * D; const GAS f32x4* xr = (const GAS f32x4*)xrow + lane;
#pragma unroll
            for (int j = 0; j < 4; ++j) nv[q][j] = xr[64 * j]; } };
    if (lo + RPT * gw < hi) ldrows(lo + RPT * gw);
    for (int m0 = lo + RPT * gw; m0 < hi; m0 += RPT * NGW) {
        f32x4 v[RPT][4];
#pragma unroll
        for (int q = 0; q < RPT; ++q)
#pragma unroll
            for (int j = 0; j < 4; ++j) v[q][j] = nv[q][j];
        if (m0 + RPT * NGW < hi) ldrows(m0 + RPT * NGW);
        asm volatile("" ::: "memory");
#pragma unroll
        for (int q = 0; q < RPT; ++q) { const int m = m0 + q; float sq = 0.f;
#pragma unroll
            for (int j = 0; j < 4; ++j) sq += (v[q][j][0] * v[q][j][0] + v[q][j][1] * v[q][j][1]) + (v[q][j][2] * v[q][j][2] + v[q][j][3] * v[q][j][3]);
            const float s = wave_sum(sq);
            GAS v2u* o8 = (GAS v2u*)(XB + (size_t)m * D) + lane;
#pragma unroll
            for (int j = 0; j < 4; ++j) { v2u w; w.x = pk2(v[q][j][0], v[q][j][1]); w.y = pk2(v[q][j][2], v[q][j][3]); o8[64 * j] = w; }
            if (lane == 0) RS[m] = __builtin_amdgcn_rsqf(s * (1.f / 1024.f) + EPS); }
    }
}
template <int PART> __device__ __forceinline__ void p0_part(Frame& F, int gw, int NGW) {
    LAS float* scr = (LAS float*)(F.lds + F.wave * 16384);
    const int lane = F.lane;
    constexpr int I_GU = 176 * 16, I_D = 32 * 44, I_IN = 120 * 16, I_O = 32 * 16;
    if constexpr (PART == 0) {
        const float *wg1 = F.in[8], *wu1 = F.in[9], *gn1 = F.in[7];
        asm volatile("" : "+s"(wg1), "+s"(wu1), "+s"(gn1));
        for (int it = gw; it < I_GU; it += NGW) { const int gi = it >> 4, kb = it & 15; const int pn = gi >> 3, q = gi & 7, bj = q >> 2, wcg = q & 3;
            const float* W = bj ? wu1 : wg1;
            p0_item<false>(W, FF, 128 * pn + 32 * wcg, 32, gn1, WSP(bf16, WS_WGU1), D, 32 * gi, 64 * kb, scr, lane); }
    } else {
        const float *wg2 = F.in[20], *wu2 = F.in[21], *gn2 = F.in[19], *wd1 = F.in[10], *wd2 = F.in[22];
        asm volatile("" : "+s"(wg2), "+s"(wu2), "+s"(gn2), "+s"(wd1), "+s"(wd2));
        for (int it = gw; it < I_GU + 2 * I_D + I_IN + I_O; it += NGW) {
            int r = it;
            if (r < I_D) { const int gi = r / 44, kb = r % 44; p0_item<false>(wd1, D, 32 * gi, 32, nullptr, WSP(bf16, WS_WD1), FF, 32 * gi, 64 * kb, scr, lane); continue; }
            r -= I_D;
            if (r < I_GU) { const int gi = r >> 4, kb = r & 15; const int pn = gi >> 3, q = gi & 7, bj = q >> 2, wcg = q & 3;
                const float* W = bj ? wu2 : wg2;
                p0_item<true>(W, FF, 128 * pn + 32 * wcg, 32, gn2, WSP(bf16, WS_WGU2), D, 32 * gi, 64 * kb, scr, lane, 32.f); continue; }
            r -= I_GU;
            if (r < I_D) { const int gi = r / 44, kb = r % 44; p0_item<true>(wd2, D, 32 * gi, 32, nullptr, WSP(bf16, WS_WD2), FF, 32 * gi, 64 * kb, scr, lane); continue; }
            r -= I_D;
            if (r < I_IN) { const int gi = r >> 4, kb = r & 15; const int pn = gi >> 3, q = gi & 7, bj = q >> 2, wcg = q & 3;
                int scol, nv = 32;
                if (pn < 4) scol = 256 * pn + 64 * wcg + 32 * bj; else if (pn < 14) scol = 256 * pn + 32 * q; else { scol = 3584; nv = (q == 0) ? 8 : 0; }
                p0_item(F.in[12], INW, scol, nv, F.in[11], WSP(bf16, WS_WIN), D, 32 * gi, 64 * kb, scr, lane); continue; }
            r -= I_IN;
            { const int gi = r >> 4, kb = r & 15; p0_item(F.in[18], D, 32 * gi, 32, nullptr, WSP(bf16, WS_WOUT), D, 32 * gi, 64 * kb, scr, lane); }
        }
    }
    if constexpr (PART == 0) p0_rows(F, MP, MT, gw, NGW);
    if constexpr (PART == 1) {
    float* rope = WSP(float, WS_ROPE);
    for (int e = (gw >> 3) * 512 + F.tid; e < NROPE * 32; e += (NGW >> 3) * 512) {
        const int prow = e >> 5, f = e & 31; const double pos = prow < SEQ ? (double)prow : (double)(PAST + prow - SEQ);
        double inv = 1.0; for (int i = 0; i < f; ++i) inv *= 0.74989420933245582730;
        const double x = pos * inv * 0.15915494309189533577;
        const double fr = x - __builtin_rint(x); const double a = fr * 6.28318530717958647693, a2 = a * a;
        double sn = 0.0, cs = 0.0;
#pragma unroll
        for (int k = 14; k >= 1; --k) { sn = 1.0 - sn * a2 / (double)((2 * k) * (2 * k + 1)); cs = 1.0 - cs * a2 / (double)((2 * k - 1) * (2 * k)); }
        sn *= a;
        rope[(size_t)prow * 64 + f] = (float)cs; rope[(size_t)prow * 64 + 32 + f] = (float)sn;
    }
    }
}

constexpr int AKS = 144;
constexpr int ABLK = 2 * 128 * AKS;
struct AttPF { v4u k[2], v[2]; bf16x8 q[2]; };
__device__ __forceinline__ void att_rc(int pat, int s, int& r, int& c) { r = pat == 0 ? 0 : pat == 1 ? (s >> 2) : s; c = pat == 0 ? s : pat == 1 ? (s & 3) : 0; }
__device__ __forceinline__ void att_load(Frame& F, int b, int h, int pat, int d, int s, AttPF& P) {
    const bf16* Qb = WSP(bf16, WS_Q); const bf16* Kb = WSP(bf16, WS_K); const bf16* Vb = WSP(bf16, WS_V);
    int r, c; att_rc(pat, s, r, c); const size_t rb = (size_t)b * SEQ + r; const int srow = F.tid >> 3, sch = F.tid & 7;
#pragma unroll
    for (int p = 0; p < 2; ++p) { const size_t ge = att_idx(rb + (size_t)d * (128 * c + srow + 64 * p), h) + sch * 8; P.k[p] = *(const GAS v4u*)(Kb + ge); P.v[p] = *(const GAS v4u*)(Vb + ge); }
    const size_t qr = rb + (size_t)d * (128 * c + 16 * F.wave + (F.lane & 15));
#pragma unroll
    for (int kk = 0; kk < 2; ++kk) P.q[kk] = *(const GAS bf16x8*)(Qb + att_idx(qr, h) + 32 * kk + 8 * (F.lane >> 4));
}
__device__ __forceinline__ void st_bf8_as_f32(float* dst, v4u w) {
    *(GAS f32x4*)dst = (f32x4){bflo(w.x), bfhi(w.x), bflo(w.y), bfhi(w.y)}; *(GAS f32x4*)(dst + 4) = (f32x4){bflo(w.z), bfhi(w.z), bflo(w.w), bfhi(w.w)};
}
__device__ __forceinline__ void att_store(Frame& F, int b, int h, int pat, int s, const AttPF& P) {
    LAS unsigned char* sl = F.lds + (s % 3) * ABLK; const int srow = F.tid >> 3, sch = F.tid & 7;
#pragma unroll
    for (int p = 0; p < 2; ++p) { *(LAS v4u*)(sl + (srow + 64 * p) * AKS + sch * 16) = P.k[p]; *(LAS v4u*)(sl + 128 * AKS + (srow + 64 * p) * AKS + sch * 16) = P.v[p]; }
}
template <bool FULL>
__device__ __forceinline__ void att_compute(const LAS unsigned char* blkP, const LAS unsigned char* blkC, const bf16x8 (&qf)[2], int w, int ql, int g, int tq, int tp, f32x4 (&o)[4], float& mx_out, float& l_out) {
    const LAS unsigned char* toff[9];
#pragma unroll
    for (int jt = 0; jt < 9; ++jt) { const int rel = 16 * w + 16 * jt; toff[jt] = FULL ? (rel < 128 ? blkP + rel * AKS : blkC + (rel - 128) * AKS) : blkC + (rel - 128) * AKS; }
    f32x4 sc[9];
    if (FULL) {
        {   bf16x8 kf[5][2];
#pragma unroll
            for (int jt = 0; jt < 5; ++jt)
#pragma unroll
                for (int kk = 0; kk < 2; ++kk) kf[jt][kk] = *(const LAS bf16x8*)(toff[jt] + ql * AKS + 16 * g + 64 * kk);
#pragma unroll
            for (int jt = 0; jt < 5; ++jt) { f32x4 a = {0.f, 0.f, 0.f, 0.f}; a = mfma16(kf[jt][0], qf[0], a); a = mfma16(kf[jt][1], qf[1], a); sc[jt] = a; } }
        {   bf16x8 kf[4][2];
#pragma unroll
            for (int jt = 0; jt < 4; ++jt)
#pragma unroll
                for (int kk = 0; kk < 2; ++kk) kf[jt][kk] = *(const LAS bf16x8*)(toff[5 + jt] + ql * AKS + 16 * g + 64 * kk);
#pragma unroll
            for (int jt = 0; jt < 4; ++jt) { f32x4 a = {0.f, 0.f, 0.f, 0.f}; a = mfma16(kf[jt][0], qf[0], a); a = mfma16(kf[jt][1], qf[1], a); sc[5 + jt] = a; } }
    } else {
#pragma unroll
        for (int jt = 0; jt < 9; ++jt) { sc[jt] = (f32x4){-1e30f, -1e30f, -1e30f, -1e30f};
            if (w + jt >= 8) { f32x4 a = {0.f, 0.f, 0.f, 0.f};
#pragma unroll
                for (int kk = 0; kk < 2; ++kk) a = mfma16(*(const LAS bf16x8*)(toff[jt] + ql * AKS + 16 * g + 64 * kk), qf[kk], a);
                sc[jt] = a; } }
    }
    float mx = -1e30f;
    if (FULL) {
        s16x4 vf[3][4][2];
#pragma unroll
        for (int jp = 0; jp < 3; ++jp) { const LAS unsigned char* a0 = toff[2 * jp] + 128 * AKS + (4 * g + tq) * AKS + 8 * tp; const LAS unsigned char* a1 = toff[2 * jp + 1] + 128 * AKS + (4 * g + tq) * AKS + 8 * tp;
#pragma unroll
            for (int dv = 0; dv < 4; ++dv) { vf[jp][dv][0] = ds_tr(a0 + 32 * dv); vf[jp][dv][1] = ds_tr(a1 + 32 * dv); } }
#pragma unroll
        for (int e4 = 0; e4 < 4; ++e4) { const int e = 4 * g + e4; sc[0][e4] = (e >= ql) ? sc[0][e4] : -1e30f; sc[8][e4] = (e <= ql) ? sc[8][e4] : -1e30f; }
#pragma unroll
        for (int jt = 0; jt < 9; ++jt) mx = fmaxf(mx, fmaxf(fmaxf(sc[jt][0], sc[jt][1]), fmaxf(sc[jt][2], sc[jt][3])));
        mx = fmaxf(mx, __shfl_xor(mx, 16)); mx = fmaxf(mx, __shfl_xor(mx, 32));
        float l = 0.f;
#pragma unroll
        for (int jt = 0; jt < 9; ++jt)
#pragma unroll
            for (int e4 = 0; e4 < 4; ++e4) { const float p = __builtin_amdgcn_exp2f(sc[jt][e4] - mx); sc[jt][e4] = p; l += p; }
        l += __shfl_xor(l, 16); l += __shfl_xor(l, 32);
#pragma unroll
        for (int dv = 0; dv < 4; ++dv) o[dv] = (f32x4){0.f, 0.f, 0.f, 0.f};
        s16x4 vg[2][4][2];
#pragma unroll
        for (int jp = 3; jp < 5; ++jp) { const LAS unsigned char* a0 = toff[2 * jp] + 128 * AKS + (4 * g + tq) * AKS + 8 * tp; const LAS unsigned char* a1 = toff[jp < 4 ? 2 * jp + 1 : 8] + 128 * AKS + (4 * g + tq) * AKS + 8 * tp;
#pragma unroll
            for (int dv = 0; dv < 4; ++dv) { vg[jp - 3][dv][0] = ds_tr(a0 + 32 * dv); vg[jp - 3][dv][1] = ds_tr(a1 + 32 * dv); } }
#pragma unroll
        for (int jp = 0; jp < 3; ++jp) { const bf16x8 pf = pack8f(sc[2 * jp], sc[2 * jp + 1]);
#pragma unroll
            for (int dv = 0; dv < 4; ++dv) o[dv] = mfma16(cat4(vf[jp][dv][0], vf[jp][dv][1]), pf, o[dv]); }
#pragma unroll
        for (int jp = 3; jp < 5; ++jp) { const bf16x8 pf = (jp < 4) ? pack8f(sc[2 * jp], sc[2 * jp + 1]) : pack8f(sc[8], (f32x4){0.f, 0.f, 0.f, 0.f});
#pragma unroll
            for (int dv = 0; dv < 4; ++dv) o[dv] = mfma16(cat4(vg[jp - 3][dv][0], vg[jp - 3][dv][1]), pf, o[dv]); }
        mx_out = mx; l_out = l;
    } else {
#pragma unroll
        for (int e4 = 0; e4 < 4; ++e4) { const int e = 4 * g + e4; sc[8][e4] = (e <= ql) ? sc[8][e4] : -1e30f; }
#pragma unroll
        for (int jt = 1; jt < 9; ++jt) if (w + jt >= 8) mx = fmaxf(mx, fmaxf(fmaxf(sc[jt][0], sc[jt][1]), fmaxf(sc[jt][2], sc[jt][3])));
        mx = fmaxf(mx, __shfl_xor(mx, 16)); mx = fmaxf(mx, __shfl_xor(mx, 32));
        float l = 0.f;
#pragma unroll
        for (int jt = 1; jt < 9; ++jt) { if (w + jt >= 8) {
#pragma unroll
                for (int e4 = 0; e4 < 4; ++e4) { const float p = __builtin_amdgcn_exp2f(sc[jt][e4] - mx); sc[jt][e4] = p; l += p; } }
            else sc[jt] = (f32x4){0.f, 0.f, 0.f, 0.f}; }
        l += __shfl_xor(l, 16); l += __shfl_xor(l, 32);
#pragma unroll
        for (int dv = 0; dv < 4; ++dv) o[dv] = (f32x4){0.f, 0.f, 0.f, 0.f};
        const LAS unsigned char* vdiag = toff[8] + 128 * AKS + (4 * g + tq) * AKS + 8 * tp;
#pragma unroll
        for (int jp = 1; jp < 5; ++jp) { const int j0 = 2 * jp - 1, j1 = 2 * jp;
            if (w + j1 >= 8) { const bf16x8 pf = pack8f(sc[j0], sc[j1]);
                const LAS unsigned char* a0 = (w + j0 >= 8) ? toff[j0] + 128 * AKS + (4 * g + tq) * AKS + 8 * tp : vdiag; const LAS unsigned char* a1 = toff[j1] + 128 * AKS + (4 * g + tq) * AKS + 8 * tp;
#pragma unroll
                for (int dv = 0; dv < 4; ++dv) o[dv] = mfma16(cat4(ds_tr(a0 + 32 * dv), ds_tr(a1 + 32 * dv)), pf, o[dv]); } }
        mx_out = mx; l_out = l;
    }
}
template <bool MERGE, int VAR = 0>
__device__ __forceinline__ void attn_step(Frame& F, int b, int h, int pat, int d, int s, AttPF& LD, const AttPF& ST, bf16x8 (&qf)[2]) {
    const int lane = F.lane, w = F.wave;
    const int ql = lane & 15, g = lane >> 4, tq = (lane & 15) >> 2, tp = lane & 3;
    int r, c; att_rc(pat, s, r, c);
    const size_t qrow = (size_t)b * SEQ + r + (size_t)d * (128 * c + 16 * w + ql);
    v2u mo0[4], mo1[4]; float l0 = 0.f, l1 = 0.f; v4u rawp0 = {0u, 0u, 0u, 0u}, rawp1 = rawp0, rawp2 = rawp0, rawp3 = rawp0;
    if (MERGE) { const bf16* OP0 = WSP(bf16, WS_OP); const bf16* OP1 = OP0 + (size_t)MP * 512; const float* L0 = WSP(float, WS_LSE); const float* L1 = L0 + (size_t)MP * 8;
        l0 = L0[att_idx(qrow, h) >> 6]; l1 = L1[att_idx(qrow, h) >> 6];
        v4u raw[4];
        raw[0] = ld16_raw(OP0 + att_idx(qrow, h), 0, 1, g); raw[1] = ld16_raw(OP0 + att_idx(qrow, h), 2, 3, g);
        raw[2] = ld16_raw(OP1 + att_idx(qrow, h), 0, 1, g); raw[3] = ld16_raw(OP1 + att_idx(qrow, h), 2, 3, g);
        rawp0 = raw[0]; rawp1 = raw[1]; rawp2 = raw[2]; rawp3 = raw[3];
        asm volatile("" ::: "memory"); }
    if (VAR != 2 && VAR != 4) { if (s + 2 < 16) att_load(F, b, h, pat, d, s + 2, LD); }
    const LAS unsigned char* blkP = F.lds + ((s + 2) % 3) * ABLK; const LAS unsigned char* blkC = F.lds + (s % 3) * ABLK;
    f32x4 o[4]; float mx, l;
    if (VAR == 5) { mx = 0.f; l = 1.f; o[0] = o[1] = o[2] = o[3] = (f32x4){0.f, 0.f, 0.f, 0.f}; }
    else if (c > 0) att_compute<true>(blkP, blkC, qf, w, ql, g, tq, tp, o, mx, l); else att_compute<false>(blkP, blkC, qf, w, ql, g, tq, tp, o, mx, l);
    const float rl = 1.f / l, lse = mx + __builtin_amdgcn_logf(l);
    if (VAR == 1 || VAR == 4 || VAR == 5) { if (lse == 123.456f) WSP(float, WS_LSE)[0] = o[0][0] + o[1][1] + o[2][2] + o[3][3]; }
    else if (!MERGE) {
        bf16* OP = WSP(bf16, WS_OP) + (size_t)pat * MP * 512; float* LSE = WSP(float, WS_LSE) + (size_t)pat * MP * 8;
        v2u wv[4];
#pragma unroll
        for (int dv = 0; dv < 4; ++dv) { wv[dv].x = pk2(o[dv][0] * rl, o[dv][1] * rl); wv[dv].y = pk2(o[dv][2] * rl, o[dv][3] * rl); }
        st16_pair(OP + att_idx(qrow, h), 0, 1, wv[0], wv[1], g); st16_pair(OP + att_idx(qrow, h), 2, 3, wv[2], wv[3], g);
        if (g == 0) LSE[att_idx(qrow, h) >> 6] = lse;
    } else {
        ul16_pair(rawp0, mo0[0], mo0[1]); ul16_pair(rawp1, mo0[2], mo0[3]); ul16_pair(rawp2, mo1[0], mo1[1]); ul16_pair(rawp3, mo1[2], mo1[3]);
        const float M = fmaxf(fmaxf(l0, l1), lse);
        float w0 = __builtin_amdgcn_exp2f(l0 - M), w1 = __builtin_amdgcn_exp2f(l1 - M), w2 = __builtin_amdgcn_exp2f(lse - M);
        const float rw = 1.f / (w0 + w1 + w2); w0 *= rw; w1 *= rw; w2 *= rw * rl;
        bf16* MIX = WSP(bf16, WS_MIX); v2u wm[4];
#pragma unroll
        for (int dv = 0; dv < 4; ++dv) { const v2u a = mo0[dv], bq = mo1[dv];
            const float y0 = w0 * bflo(a.x) + w1 * bflo(bq.x) + w2 * o[dv][0], y1 = w0 * bfhi(a.x) + w1 * bfhi(bq.x) + w2 * o[dv][1];
            const float y2 = w0 * bflo(a.y) + w1 * bflo(bq.y) + w2 * o[dv][2], y3 = w0 * bfhi(a.y) + w1 * bfhi(bq.y) + w2 * o[dv][3];
            wm[dv].x = pk2(y0, y1); wm[dv].y = pk2(y2, y3); }
        st16_pair(MIX + qrow * 1024 + h * 64, 0, 1, wm[0], wm[1], g); st16_pair(MIX + qrow * 1024 + h * 64, 2, 3, wm[2], wm[3], g);
    }
    if (VAR != 4) { if (s + 1 < 16) { att_store(F, b, h, pat, s + 1, ST); qf[0] = ST.q[0]; qf[1] = ST.q[1]; } }
    __syncthreads();
}
template <bool MERGE, int VAR = 0>
__device__ __forceinline__ void attn_seq_unit(Frame& F, int b, int h, int pat) {
    if (VAR == 3) pat = 0;
    const int d = pat == 0 ? 1 : pat == 1 ? 4 : 16;
    AttPF A, B; bf16x8 qf[2];
    att_load(F, b, h, pat, d, 0, A); att_load(F, b, h, pat, d, 1, B);
    att_store(F, b, h, pat, 0, A); qf[0] = A.q[0]; qf[1] = A.q[1];
    __syncthreads();
    for (int s = 0; s < 16; s += 2) {
        attn_step<MERGE, VAR>(F, b, h, pat, d, s, A, B, qf);
        attn_step<MERGE, VAR>(F, b, h, pat, d, s + 1, B, A, qf);
    }
}

__device__ __forceinline__ float dpp_sum16(float x) {
    x += __builtin_bit_cast(float, __builtin_amdgcn_update_dpp(0, __builtin_bit_cast(int, x), 0xB1, 0xF, 0xF, true));
    x += __builtin_bit_cast(float, __builtin_amdgcn_update_dpp(0, __builtin_bit_cast(int, x), 0x4E, 0xF, 0xF, true));
    x += __builtin_bit_cast(float, __builtin_amdgcn_update_dpp(0, __builtin_bit_cast(int, x), 0x141, 0xF, 0xF, true));
    x += __builtin_bit_cast(float, __builtin_amdgcn_update_dpp(0, __builtin_bit_cast(int, x), 0x140, 0xF, 0xF, true));
    return x;
}
__device__ __forceinline__ void sattn_unit(Frame& F, int idx) {
    const int b = idx >> 2, t = idx & 3, lane = F.lane, hh = F.wave;
    const int R = MP + b * 4 + t;
    const bf16* Qb = WSP(bf16, WS_Q);
    const float* cK = F.in[2] + ((size_t)b * WINB * 512 + hh * 64); const float* cV = F.in[3] + ((size_t)b * WINB * 512 + hh * 64);
    const float* nK = F.out + O_KS + ((size_t)b * 4 * 512 + hh * 64); const float* nV = F.out + O_VS + ((size_t)b * 4 * 512 + hh * 64);
    const int ks = lane >> 4, c16 = lane & 15;
    float q4[4];
    { const v2u qw = *(const GAS v2u*)(Qb + att_idx(R, hh) + 4 * c16); q4[0] = bflo(qw.x); q4[1] = bfhi(qw.x); q4[2] = bflo(qw.y); q4[3] = bfhi(qw.y); }
    float mx = -1e30f, l = 0.f; float o4[4] = {0.f, 0.f, 0.f, 0.f};
#pragma unroll
    for (int pat = 0; pat < 3; ++pat) { const int d = pat == 0 ? 1 : pat == 1 ? 4 : 16;
#pragma unroll 1
        for (int ib = 0; ib < 3; ++ib) { f32x4 k4[11], v4[11]; float sv[11];
#pragma unroll
            for (int u = 0; u < 11; ++u) { const int i = 11 * ib + u; const int j = 4 * i + ks; const int jj = j <= 128 ? j : 128; const int rr = WINB + t - d * jj;
                const size_t ro = rr >= WINB ? (size_t)(rr - WINB) * 512 : (size_t)rr * 512;
                k4[u] = *(const GAS f32x4*)((rr >= WINB ? nK : cK) + ro + 4 * c16); v4[u] = *(const GAS f32x4*)((rr >= WINB ? nV : cV) + ro + 4 * c16); }
            float bm = -1e30f;
#pragma unroll
            for (int u = 0; u < 11; ++u) { const int i = 11 * ib + u; const bool valid = (4 * i + ks) <= 128;
                float part = dpp_sum16((q4[0] * k4[u][0] + q4[1] * k4[u][1]) + (q4[2] * k4[u][2] + q4[3] * k4[u][3]));
                part = valid ? part : -1e30f; sv[u] = part; bm = fmaxf(bm, part); }
            const float mn = fmaxf(mx, bm), rs = __builtin_amdgcn_exp2f(mx - mn); mx = mn;
            l *= rs; o4[0] *= rs; o4[1] *= rs; o4[2] *= rs; o4[3] *= rs;
#pragma unroll
            for (int u = 0; u < 11; ++u) { const float p = __builtin_amdgcn_exp2f(sv[u] - mx); l += p;
                o4[0] += p * v4[u][0]; o4[1] += p * v4[u][1]; o4[2] += p * v4[u][2]; o4[3] += p * v4[u][3]; } } }
    float M = fmaxf(mx, __shfl_xor(mx, 16)); M = fmaxf(M, __shfl_xor(M, 32));
    const float fs = __builtin_amdgcn_exp2f(mx - M); l *= fs;
    l += __shfl_xor(l, 16); l += __shfl_xor(l, 32);
    const float rl = 1.f / l;
#pragma unroll
    for (int k = 0; k < 4; ++k) { o4[k] *= fs; o4[k] += __shfl_xor(o4[k], 16); o4[k] += __shfl_xor(o4[k], 32); o4[k] *= rl; }
    if (ks == 0) { v2u wv; wv.x = pk2(o4[0], o4[1]); wv.y = pk2(o4[2], o4[3]); *(GAS v2u*)(WSP(bf16, WS_MIX) + (size_t)R * 1024 + hh * 64 + 4 * c16) = wv; }
}

__device__ __forceinline__ void smlstm_unit(Frame& F, int idx) {
    const int b = idx >> 2, h = idx & 3, tid = F.tid, lane = F.lane, w = F.wave;
    LAS float* qv = (LAS float*)(F.lds); LAS float* kv = qv + 512; LAS float* dots = kv + 512; LAS float* scal = dots + 32;
    LAS float* qcp = (LAS float*)(F.lds + 8192); LAS float* hsq = (LAS float*)(F.lds + 49152);
    const int R0 = MP + b * 4; const int bh = b * 4 + h;
    const bf16* MQ = WSP(bf16, WS_MQ); const bf16* MK = WSP(bf16, WS_MK); const bf16* MV = WSP(bf16, WS_MV); const bf16* MO = WSP(bf16, WS_MO); const float* G = WSP(float, WS_G);
    const float* C0 = F.in[4] + (size_t)bh * DK * DK; const float* n0 = F.in[5] + (size_t)bh * DK;
    { const int t = tid >> 7, j = tid & 127; const unsigned short q_ = MQ[ml_idx(R0 + t, h) + j], k_ = MK[ml_idx(R0 + t, h) + j]; asm volatile("" ::: "memory"); qv[tid] = bf2f(q_); kv[tid] = bf2f(k_); }
    __syncthreads();
    for (int di = w; di < 20; di += 8) { float x;
        if (di < 16) { const int t = di >> 2, s = di & 3; x = qv[t * 128 + lane] * kv[s * 128 + lane] + qv[t * 128 + lane + 64] * kv[s * 128 + lane + 64]; }
        else { const int t = di - 16; x = qv[t * 128 + lane] * n0[lane] + qv[t * 128 + lane + 64] * n0[lane + 64]; }
        x = wave_sum(x); if (lane == 0) dots[di] = x; }
    __syncthreads();
    if (tid == 0) {
        const float m0 = F.in[6][bh]; float lf[4], ig[4], bc[4];
#pragma unroll
        for (int t = 0; t < 4; ++t) { ig[t] = G[(size_t)(R0 + t) * 8 + h]; lf[t] = G[(size_t)(R0 + t) * 8 + 4 + h]; }
        bc[0] = lf[0]; bc[1] = bc[0] + lf[1]; bc[2] = bc[1] + lf[2]; bc[3] = bc[2] + lf[3];
#pragma unroll
        for (int t = 0; t < 4; ++t) { const float inter = bc[t] + m0; float mt = inter; float dd[4];
#pragma unroll
            for (int s = 0; s < 4; ++s) { dd[s] = bc[t] - bc[s] + ig[s]; if (s <= t) mt = fmaxf(mt, dd[s]); }
            float den = 0.f;
#pragma unroll
            for (int s = 0; s < 4; ++s) { const float a = (s <= t) ? expf(dd[s] - mt) * dots[t * 4 + s] : 0.f; scal[t * 4 + s] = a; den += a; }
            const float wi = expf(inter - mt); den += wi * dots[16 + t]; den = fmaxf(fabsf(den), expf(-mt));
            scal[16 + t] = wi; scal[20 + t] = 1.f / den; }
        const float bl = bc[3]; float mn = bl + m0; float gs[4];
#pragma unroll
        for (int s = 0; s < 4; ++s) { gs[s] = bl - bc[s] + ig[s]; mn = fmaxf(mn, gs[s]); }
#pragma unroll
        for (int s = 0; s < 4; ++s) scal[24 + s] = expf(gs[s] - mn);
        scal[28] = expf(bl + m0 - mn);
        F.out[O_MS + bh] = mn;
    }
    __syncthreads();
    {
        const int vq = tid & 31, kg = tid >> 5; LAS float* vls = (LAS float*)(F.lds + 4608);
        f32x4 c4[8];
#pragma unroll
        for (int kk = 0; kk < 8; ++kk) c4[kk] = *(const GAS f32x4*)(C0 + (size_t)(8 * kg + kk) * 128 + 4 * vq);
        f32x4 wsv[4]; v2u mvw[4];
#pragma unroll
        for (int s = 0; s < 4; ++s) mvw[s] = *(const GAS v2u*)(MV + ml_idx(R0 + s, h) + 4 * vq);
        asm volatile("" ::: "memory");
#pragma unroll
        for (int s = 0; s < 4; ++s) { const v2u w = mvw[s]; const f32x4 vv = {bflo(w.x), bfhi(w.x), bflo(w.y), bfhi(w.y)};
            if (kg == 0) *(LAS f32x4*)(vls + s * 128 + 4 * vq) = vv; wsv[s] = vv * scal[24 + s]; }
        const float wc = scal[28];
        f32x4 qc[4];
#pragma unroll
        for (int t = 0; t < 4; ++t) qc[t] = (f32x4){0.f, 0.f, 0.f, 0.f};
        float* Cout = F.out + O_CS + (size_t)bh * DK * DK;
#pragma unroll
        for (int kk = 0; kk < 8; ++kk) { const int k = 8 * kg + kk;
#pragma unroll
            for (int t = 0; t < 4; ++t) qc[t] += c4[kk] * qv[t * 128 + k];
            const f32x4 cn = c4[kk] * wc + (wsv[0] * kv[k] + wsv[1] * kv[128 + k]) + (wsv[2] * kv[256 + k] + wsv[3] * kv[384 + k]);
            *(GAS f32x4*)(Cout + (size_t)k * 128 + 4 * vq) = cn; }
#pragma unroll
        for (int t = 0; t < 4; ++t) *(LAS f32x4*)(qcp + (kg * 4 + t) * 128 + 4 * vq) = qc[t];
        if (tid < 128) F.out[O_NS + (size_t)bh * DK + tid] = wc * n0[tid] + (scal[24] * kv[tid] + scal[25] * kv[128 + tid]) + (scal[26] * kv[256 + tid] + scal[27] * kv[384 + tid]);
    }
    __syncthreads();
    { const int v = tid & 127, t = tid >> 7; LAS float* vls = (LAS float*)(F.lds + 4608);
        float num = (scal[t * 4 + 0] * vls[v] + scal[t * 4 + 1] * vls[128 + v]) + (scal[t * 4 + 2] * vls[256 + v] + scal[t * 4 + 3] * vls[384 + v]);
        float qs = 0.f;
#pragma unroll
        for (int kg = 0; kg < 16; ++kg) qs += qcp[(kg * 4 + t) * 128 + v];
        num += scal[16 + t] * qs;
        const float hv = num * scal[20 + t];
        const float sq = wave_sum(hv * hv); if (lane == 0) hsq[w] = sq;
        __syncthreads();
        const float tot = hsq[2 * t] + hsq[2 * t + 1];
        const float inv = __builtin_amdgcn_rsqf(tot * (1.f / 128.f) + EPS);
        const float y = hv * inv * F.in[17][h * 128 + v] * bf2f(MO[ml_idx(R0 + t, h) + v]);
        WSP(bf16, WS_MIX)[(size_t)(R0 + t) * 1024 + 512 + h * 128 + v] = (bf16)(pk2(y, 0.f) & 0xffffu);
    }
    __syncthreads();
}

constexpr int MKS = 272;
__device__ __forceinline__ void mlstm1_unit(Frame& F, int bh) {
    const int b = bh >> 2, h = bh & 3, tid = F.tid, lane = F.lane, w = F.wave;
    LAS unsigned char* Ks = F.lds; LAS unsigned char* Vs = F.lds + 128 * MKS;
    LAS float* wsv = (LAS float*)(F.lds + 2 * 128 * MKS); LAS float* blv = wsv + 2048; LAS float* gmv = blv + 16; LAS float* mvec = gmv + 16; LAS float* wcv = mvec + 32; LAS float* npart = wcv + 16;
    const float* G = WSP(float, WS_G); const bf16* MK = WSP(bf16, WS_MK); const bf16* MV = WSP(bf16, WS_MV);
    const size_t row0 = (size_t)b * SEQ;
    {
        float lf[4], ig[4], cs[4];
#pragma unroll
        for (int j = 0; j < 4; ++j) { ig[j] = G[(row0 + 4 * tid + j) * 8 + h]; lf[j] = G[(row0 + 4 * tid + j) * 8 + 4 + h]; }
        cs[0] = lf[0]; cs[1] = cs[0] + lf[1]; cs[2] = cs[1] + lf[2]; cs[3] = cs[2] + lf[3];
        float x = cs[3];
#pragma unroll
        for (int off = 1; off < 32; off <<= 1) { const float y = __shfl_up(x, off, 32); if ((lane & 31) >= off) x += y; }
        const float excl = x - cs[3]; const float bl = __shfl(x, 31, 32);
        float gj[4], gm = -1e30f;
#pragma unroll
        for (int j = 0; j < 4; ++j) { gj[j] = bl - (excl + cs[j]) + ig[j]; gm = fmaxf(gm, gj[j]); }
#pragma unroll
        for (int off = 1; off < 32; off <<= 1) gm = fmaxf(gm, __shfl_xor(gm, off));
        const int ch = tid >> 5;
        if ((lane & 31) == 0) { blv[ch] = bl; gmv[ch] = gm; }
        __syncthreads();
        if (tid == 0) { float m = 0.f; mvec[0] = 0.f;
            for (int c = 0; c < 16; ++c) { const float mn = fmaxf(blv[c] + m, gmv[c]); wcv[c] = expf(blv[c] + m - mn); m = mn; mvec[c + 1] = m; } }
        __syncthreads();
        const float mnew = mvec[ch + 1];
#pragma unroll
        for (int j = 0; j < 4; ++j) wsv[4 * tid + j] = expf(gj[j] - mnew);
        if (tid < 16) WSP(float, WS_MC)[bh * 16 + tid] = mvec[tid];
        if (tid == 16) F.out[O_MP + bh] = mvec[16];
    }
    __syncthreads();
    const int ql = lane & 15, g = lane >> 4, tq = (lane & 15) >> 2, tp = lane & 3, dkg = w >> 1, dvg = w & 1;
    f32x4 acc[2][4];
#pragma unroll
    for (int a = 0; a < 2; ++a)
#pragma unroll
        for (int q = 0; q < 4; ++q) acc[a][q] = (f32x4){0.f, 0.f, 0.f, 0.f};
    float nacc = 0.f;
    bf16* CTg = WSP(bf16, WS_CT); float* NCg = WSP(float, WS_NC);
    v4u pkx[4], pvx[4];
#pragma unroll
    for (int p = 0; p < 4; ++p) { const int id = p * 512 + tid, rr = id >> 4, ch = id & 15; const size_t ge = ml_idx(row0 + rr, h) + ch * 8; pkx[p] = *(const GAS v4u*)(MK + ge); pvx[p] = *(const GAS v4u*)(MV + ge); }
    for (int c = 0; c < 16; ++c) {
#pragma unroll
        for (int a = 0; a < 2; ++a)
#pragma unroll
            for (int q = 0; q < 4; ++q) { const int dk0 = 16 * (2 * dkg + a) + 4 * g, dv = 16 * (4 * dvg + q) + ql;
                v2u wv; wv.x = pk2(acc[a][q][0], acc[a][q][1]); wv.y = pk2(acc[a][q][2], acc[a][q][3]);
                *(GAS v2u*)(CTg + ((size_t)(bh * 16 + c) * 128 + dv) * 128 + dk0) = wv; }
        if (tid < 128) NCg[(size_t)(bh * 16 + c) * 128 + tid] = nacc;
#pragma unroll
        for (int p = 0; p < 4; ++p) { const int id = p * 512 + tid, rr = id >> 4, ch = id & 15;
            const v4u kx = pkx[p]; v4u vx = pvx[p]; const float ws = wsv[128 * c + rr];
            vx.x = pk2(bflo(vx.x) * ws, bfhi(vx.x) * ws); vx.y = pk2(bflo(vx.y) * ws, bfhi(vx.y) * ws); vx.z = pk2(bflo(vx.z) * ws, bfhi(vx.z) * ws); vx.w = pk2(bflo(vx.w) * ws, bfhi(vx.w) * ws);
            *(LAS v4u*)(Ks + rr * MKS + ch * 16) = kx; *(LAS v4u*)(Vs + rr * MKS + ch * 16) = vx; }
        __syncthreads();
        if (c < 15) {
#pragma unroll
            for (int p = 0; p < 4; ++p) { const int id = p * 512 + tid, rr = id >> 4, ch = id & 15; const size_t ge = ml_idx(row0 + 128 * (c + 1) + rr, h) + ch * 8; pkx[p] = *(const GAS v4u*)(MK + ge); pvx[p] = *(const GAS v4u*)(MV + ge); } }
        {
            const int dk = tid & 127, sq = tid >> 7; float part = 0.f;
#pragma unroll 8
            for (int s = 32 * sq; s < 32 * sq + 32; ++s) part += wsv[128 * c + s] * bf2f(*(const LAS unsigned short*)(Ks + s * MKS + dk * 2));
            npart[sq * 128 + dk] = part; }
        const float wcc = wcv[c];
#pragma unroll
        for (int a = 0; a < 2; ++a)
#pragma unroll
            for (int q = 0; q < 4; ++q) acc[a][q] = acc[a][q] * wcc;
#pragma unroll
        for (int ks = 0; ks < 4; ++ks) { bf16x8 af[2], bfr[4];
            const int r0 = 32 * ks + 8 * g + tq;
#pragma unroll
            for (int a = 0; a < 2; ++a) { const int col = 16 * (2 * dkg + a) + 4 * tp; af[a] = cat4(ds_tr(Ks + r0 * MKS + col * 2), ds_tr(Ks + (r0 + 4) * MKS + col * 2)); }
#pragma unroll
            for (int q = 0; q < 4; ++q) { const int col = 16 * (4 * dvg + q) + 4 * tp; bfr[q] = cat4(ds_tr(Vs + r0 * MKS + col * 2), ds_tr(Vs + (r0 + 4) * MKS + col * 2)); }
#pragma unroll
            for (int a = 0; a < 2; ++a)
#pragma unroll
                for (int q = 0; q < 4; ++q) acc[a][q] = mfma16(af[a], bfr[q], acc[a][q]); }
        __syncthreads();
        if (tid < 128) nacc = wcc * nacc + ((npart[tid] + npart[128 + tid]) + (npart[256 + tid] + npart[384 + tid]));
    }
    float* Cout = F.out + O_CP + (size_t)bh * DK * DK;
#pragma unroll
    for (int a = 0; a < 2; ++a)
#pragma unroll
        for (int q = 0; q < 4; ++q) { const int dk0 = 16 * (2 * dkg + a) + 4 * g, dv = 16 * (4 * dvg + q) + ql;
#pragma unroll
            for (int e = 0; e < 4; ++e) Cout[(size_t)(dk0 + e) * 128 + dv] = acc[a][q][e]; }
    if (tid < 128) F.out[O_NP + (size_t)bh * DK + tid] = nacc;
    __syncthreads();
}

__device__ __forceinline__ void ml2_issue(Frame& F, int idx, v4u (&sk)[4], v4u (&sv)[4], v4u (&sc4)[4]) {
    const int bh = idx >> 4, c = idx & 15, b = bh >> 2, h = bh & 3, tid = F.tid;
    const bf16* MK = WSP(bf16, WS_MK); const bf16* MV = WSP(bf16, WS_MV); const bf16* CTg = WSP(bf16, WS_CT) + (size_t)(bh * 16 + c) * DK * DK;
    const size_t row0 = (size_t)b * SEQ + 128 * c;
#pragma unroll
    for (int p = 0; p < 4; ++p) { const int id = p * 512 + tid, rr = id >> 4, ch = id & 15; const size_t ge = ml_idx(row0 + rr, h) + ch * 8;
        sk[p] = *(const GAS v4u*)(MK + ge); sv[p] = *(const GAS v4u*)(MV + ge); sc4[p] = *(const GAS v4u*)(CTg + (size_t)rr * 128 + ch * 8); }
    asm volatile("" ::: "memory");
}
__device__ __forceinline__ void mlstm2_seq(Frame& F, int idx0, int stride, int nunits) {
    v4u sk[4], sv[4], sc4[4];
    if (idx0 < nunits) ml2_issue(F, idx0, sk, sv, sc4);
    for (int idx = idx0; idx < nunits; idx += stride) {
    const int bh = idx >> 4, c = idx & 15, b = bh >> 2, h = bh & 3, tid = F.tid, lane = F.lane, w = F.wave;
    LAS unsigned char* Ks = F.lds; LAS unsigned char* Vs = F.lds + 128 * MKS; LAS unsigned char* Cs = F.lds + 2 * 128 * MKS;
    LAS float* bvec = (LAS float*)(F.lds + 3 * 128 * MKS); LAS float* avec = bvec + 128; LAS float* mtv = avec + 128; LAS float* nvec = mtv + 128;
    const float* G = WSP(float, WS_G); const bf16* MQ = WSP(bf16, WS_MQ); const bf16* MK = WSP(bf16, WS_MK); const bf16* MV = WSP(bf16, WS_MV); const bf16* MO = WSP(bf16, WS_MO);
    const bf16* CTg = WSP(bf16, WS_CT) + (size_t)(bh * 16 + c) * DK * DK; const float* NCg = WSP(float, WS_NC) + (size_t)(bh * 16 + c) * DK;
    const size_t row0 = (size_t)b * SEQ + 128 * c;
    const float mc = WSP(float, WS_MC)[bh * 16 + c];
    {
#pragma unroll
        for (int p = 0; p < 4; ++p) { const int id = p * 512 + tid, rr = id >> 4, ch = id & 15;
            *(LAS v4u*)(Ks + rr * MKS + ch * 16) = sk[p]; *(LAS v4u*)(Vs + rr * MKS + ch * 16) = sv[p]; *(LAS v4u*)(Cs + rr * MKS + ch * 16) = sc4[p]; } }
    if (w == 0) {
        const int s0 = 2 * lane;
        const float lf0 = G[(row0 + s0) * 8 + 4 + h], lf1 = G[(row0 + s0 + 1) * 8 + 4 + h], ig0 = G[(row0 + s0) * 8 + h], ig1 = G[(row0 + s0 + 1) * 8 + h];
        float x = lf0 + lf1;
#pragma unroll
        for (int off = 1; off < 64; off <<= 1) { const float y = __shfl_up(x, off); if (lane >= off) x += y; }
        const float b1 = x, b0 = x - lf1; const float a0 = ig0 - b0, a1 = ig1 - b1;
        float pm = fmaxf(a0, a1);
#pragma unroll
        for (int off = 1; off < 64; off <<= 1) { const float y = __shfl_up(pm, off); if (lane >= off) pm = fmaxf(pm, y); }
        float pe = __shfl_up(pm, 1); if (lane == 0) pe = -1e30f;
        const float pm0 = fmaxf(pe, a0), pm1 = pm;
        const float L2E = 1.4426950408889634f;
        bvec[s0] = b0 * L2E; bvec[s0 + 1] = b1 * L2E; avec[s0] = a0 * L2E; avec[s0 + 1] = a1 * L2E; mtv[s0] = (b0 + fmaxf(mc, pm0)) * L2E; mtv[s0 + 1] = (b1 + fmaxf(mc, pm1)) * L2E;
    }
    if (w == 1) { const float n0_ = NCg[lane], n1_ = NCg[lane + 64]; asm volatile("" ::: "memory"); nvec[lane] = n0_; nvec[lane + 64] = n1_; }
    const int ql = lane & 15, g = lane >> 4, tq = (lane & 15) >> 2, tp = lane & 3;
    const int t = 16 * w + ql; const size_t row = row0 + t;
    bf16x8 qf[4];
#pragma unroll
    for (int kk = 0; kk < 4; ++kk) qf[kk] = *(const GAS bf16x8*)(MQ + ml_idx(row, h) + 32 * kk + 8 * g);
    __syncthreads();
    if (idx + stride < nunits) ml2_issue(F, idx + stride, sk, sv, sc4);
    asm volatile("" ::: "memory");
    const float mtt = mtv[t], et = bvec[t] - mtt, winter = __builtin_amdgcn_exp2f(et + mc * 1.4426950408889634f);
    f32x4 st[8]; float dsum = 0.f;
#pragma unroll
    for (int js = 0; js < 8; ++js) { st[js] = (f32x4){0.f, 0.f, 0.f, 0.f};
        if (js <= w) { f32x4 a = {0.f, 0.f, 0.f, 0.f};
#pragma unroll
            for (int kk = 0; kk < 4; ++kk) { const bf16x8 kf = *(const LAS bf16x8*)(Ks + (16 * js + ql) * MKS + 64 * kk + 16 * g); a = mfma16(kf, qf[kk], a); }
            const f32x4 av = *(const LAS f32x4*)(avec + 16 * js + 4 * g);
#pragma unroll
            for (int e = 0; e < 4; ++e) { const int s = 16 * js + 4 * g + e; const float val = (s <= t) ? __builtin_amdgcn_exp2f(et + av[e]) * a[e] : 0.f; st[js][e] = val; dsum += val; } } }
    dsum += __shfl_xor(dsum, 16); dsum += __shfl_xor(dsum, 32);
    float qn = 0.f;
#pragma unroll
    for (int kk = 0; kk < 4; ++kk) { const f32x4 n0 = *(const LAS f32x4*)(nvec + 32 * kk + 8 * g), n1 = *(const LAS f32x4*)(nvec + 32 * kk + 8 * g + 4);
        qn += (bf2f((unsigned short)qf[kk][0]) * n0[0] + bf2f((unsigned short)qf[kk][1]) * n0[1]) + (bf2f((unsigned short)qf[kk][2]) * n0[2] + bf2f((unsigned short)qf[kk][3]) * n0[3])
            + (bf2f((unsigned short)qf[kk][4]) * n1[0] + bf2f((unsigned short)qf[kk][5]) * n1[1]) + (bf2f((unsigned short)qf[kk][6]) * n1[2] + bf2f((unsigned short)qf[kk][7]) * n1[3]); }
    qn += __shfl_xor(qn, 16); qn += __shfl_xor(qn, 32);
    float den = dsum + winter * qn; den = fmaxf(fabsf(den), __builtin_amdgcn_exp2f(-mtt));
    f32x4 o[8];
#pragma unroll
    for (int dv = 0; dv < 8; ++dv) o[dv] = (f32x4){0.f, 0.f, 0.f, 0.f};
#pragma unroll
    for (int jp = 0; jp < 4; ++jp) if (2 * jp <= w) { const bf16x8 pf = pack8f(st[2 * jp], st[2 * jp + 1]); const int r0 = 32 * jp + 4 * g + tq;
#pragma unroll
        for (int dv = 0; dv < 8; ++dv) { const int col = 16 * dv + 4 * tp; o[dv] = mfma16(cat4(ds_tr(Vs + r0 * MKS + col * 2), ds_tr(Vs + (r0 + 16) * MKS + col * 2)), pf, o[dv]); } }
    f32x4 gvv[8]; v2u mov[8];
    { const float* gn_ = F.in[17] + h * 128;
#pragma unroll
        for (int dv = 0; dv < 8; ++dv) { const int col = 16 * dv + 4 * g; gvv[dv] = *(const GAS f32x4*)(gn_ + col); mov[dv] = *(const GAS v2u*)(MO + ml_idx(row, h) + col); } }
    bf16x8 qs[4];
#pragma unroll
    for (int kk = 0; kk < 4; ++kk) { f32x4 lo, hi;
#pragma unroll
        for (int e = 0; e < 4; ++e) { lo[e] = bf2f((unsigned short)qf[kk][e]) * winter; hi[e] = bf2f((unsigned short)qf[kk][4 + e]) * winter; }
        qs[kk] = pack8f(lo, hi); }
#pragma unroll
    for (int dv = 0; dv < 8; ++dv)
#pragma unroll
        for (int kk = 0; kk < 4; ++kk) { const bf16x8 cf = *(const LAS bf16x8*)(Cs + (16 * dv + ql) * MKS + 64 * kk + 16 * g); o[dv] = mfma16(cf, qs[kk], o[dv]); }
    const float rden = 1.f / den; float ssq = 0.f;
#pragma unroll
    for (int dv = 0; dv < 8; ++dv) { o[dv] = o[dv] * rden; ssq += (o[dv][0] * o[dv][0] + o[dv][1] * o[dv][1]) + (o[dv][2] * o[dv][2] + o[dv][3] * o[dv][3]); }
    ssq += __shfl_xor(ssq, 16); ssq += __shfl_xor(ssq, 32);
    const float inv = __builtin_amdgcn_rsqf(ssq * (1.f / 128.f) + EPS);
    bf16* MIX = WSP(bf16, WS_MIX); const float* gn = F.in[17] + h * 128; v2u wm[8];
#pragma unroll
    for (int dv = 0; dv < 8; ++dv) { const int col = 16 * dv + 4 * g; const f32x4 gv = gvv[dv]; const v2u mo = mov[dv];
        const float y0 = o[dv][0] * inv * gv[0] * bflo(mo.x), y1 = o[dv][1] * inv * gv[1] * bfhi(mo.x), y2 = o[dv][2] * inv * gv[2] * bflo(mo.y), y3 = o[dv][3] * inv * gv[3] * bfhi(mo.y);
        wm[dv].x = pk2(y0, y1); wm[dv].y = pk2(y2, y3); }
#pragma unroll
    for (int dp = 0; dp < 4; ++dp) st16_pair(MIX + row * 1024 + 512 + h * 128, 2 * dp, 2 * dp + 1, wm[2 * dp], wm[2 * dp + 1], g);
    __syncthreads();
    }
}


constexpr int N_PHASES = 9;
constexpr int U4_ML1 = 128, U4_SATT = 512, U4_SML = 512, U4_ATT = 512;
constexpr int U5_ML2 = 2048, U5_ATT = 256;

__device__ __forceinline__ int queue_next(Frame& F, int word) {
    __syncthreads();
    if (F.tid == 0) F.MISC[4] = __hip_atomic_fetch_add((unsigned*)(F.ctl + word), 1u, RLX_AGENT);
    __syncthreads();
    return __builtin_amdgcn_readfirstlane((int)F.MISC[4]);
}

template <int MODE, int nS> __device__ __forceinline__ void reduce_tail(Frame& F, float alpha) {
    const float* SLAB = WSP(float, WS_SLAB); bf16* XB = WSP(bf16, WS_XB); const float* SS = WSP(float, WS_SS); float* RS = WSP(float, WS_RS);
    for (int rr = (int)blockIdx.x * 2; rr < MS; rr += F.G * 2) { const int row = rr + (F.tid >> 8), col = (F.tid & 255) * 4;
        f32x4 a = {0.f, 0.f, 0.f, 0.f};
        v2u sw[nS];
#pragma unroll
        for (int ks = 0; ks < nS; ++ks) sw[ks] = *(const GAS v2u*)((const bf16*)SLAB + ((size_t)ks * 512 + row) * 1024 + col);
#pragma unroll
        for (int ks = 0; ks < nS; ++ks) a += (f32x4){bflo(sw[ks].x), bfhi(sw[ks].x), bflo(sw[ks].y), bfhi(sw[ks].y)};
        f32x4 res;
        if (MODE == 0) res = *(const GAS f32x4*)(F.in[1] + (size_t)row * 1024 + col);
        else { const v2u w = *(const GAS v2u*)(XB + (size_t)(MP + row) * 1024 + col); res = (f32x4){bflo(w.x), bfhi(w.x), bflo(w.y), bfhi(w.y)}; }
        const f32x4 v = res + a * alpha;
        if (MODE == 2) *(GAS f32x4*)(F.out + O_Y + (size_t)(MP + row) * 1024 + col) = v;
        else { v2u w; w.x = pk2(v[0], v[1]); w.y = pk2(v[2], v[3]); *(GAS v2u*)(XB + (size_t)(MP + row) * 1024 + col) = w;
            if (MODE == 1) { int q = 0; q = __builtin_amdgcn_cvt_pk_fp8_f32(__builtin_amdgcn_fmed3f(v[0] * 16.f, -448.f, 448.f), __builtin_amdgcn_fmed3f(v[1] * 16.f, -448.f, 448.f), q, false);
                q = __builtin_amdgcn_cvt_pk_fp8_f32(__builtin_amdgcn_fmed3f(v[2] * 16.f, -448.f, 448.f), __builtin_amdgcn_fmed3f(v[3] * 16.f, -448.f, 448.f), q, true);
                *(GAS unsigned*)(WSP(unsigned char, WS_X8) + (size_t)(MP + row) * 1024 + col) = (unsigned)q; }
            const float ss = wave_sum((v[0] * v[0] + v[1] * v[1]) + (v[2] * v[2] + v[3] * v[3]));
            LAS float* red = (LAS float*)F.lds;
            __syncthreads(); if (F.lane == 0) red[F.wave] = ss; __syncthreads();
            if ((F.tid & 255) == 0) { const int w0 = F.wave; RS[MP + row] = __builtin_amdgcn_rsqf(((red[w0] + red[w0 + 1]) + (red[w0 + 2] + red[w0 + 3])) * (1.f / 1024.f) + EPS); } }
    }
    if (MODE != 2) {
        for (int row = (int)blockIdx.x * 512 + F.tid; row < MP; row += F.G * 512) { const GAS f32x4* p = (const GAS f32x4*)(SS + (size_t)row * 16); const f32x4 a = p[0], b = p[1], c = p[2], d = p[3];
            const float s = ((a[0] + a[1]) + (a[2] + a[3])) + ((b[0] + b[1]) + (b[2] + b[3])) + ((c[0] + c[1]) + (c[2] + c[3])) + ((d[0] + d[1]) + (d[2] + d[3]));
            RS[row] = __builtin_amdgcn_rsqf(s * (1.f / 1024.f) + EPS); }
    }
}

__device__ __forceinline__ void ctl_publish(Frame& F, int word) {
    __builtin_amdgcn_s_waitcnt(0x0F70); asm volatile("" ::: "memory");
    __syncthreads();
    if (F.tid == 0) { __builtin_amdgcn_fence(__ATOMIC_RELEASE, "agent"); asm volatile("s_waitcnt vmcnt(0)" ::: "memory");
        (void)__hip_atomic_fetch_add((unsigned*)(F.ctl + word), 1u, RLX_AGENT); }
}
__device__ __forceinline__ void ctl_acquire(Frame& F, int word, unsigned need) {
    __syncthreads();
    if (F.tid == 0) { unsigned v = __hip_atomic_load((unsigned*)(F.ctl + word), RLX_AGENT);
        unsigned sp = 0; while (v < need && sp < (1u << 22)) { __builtin_amdgcn_s_sleep(2); ++sp; v = __hip_atomic_load((unsigned*)(F.ctl + word), RLX_AGENT); }
        __builtin_amdgcn_fence(__ATOMIC_ACQUIRE, "agent"); asm volatile("s_waitcnt vmcnt(0)" ::: "memory"); }
    __syncthreads();
}

constexpr int N_SUNITS = 2 * (INP / 256);
__device__ __forceinline__ void sample_publish(Frame& F) {
    __builtin_amdgcn_s_waitcnt(0x0F70); asm volatile("" ::: "memory");
    __syncthreads();
    if (F.tid == 0) { __builtin_amdgcn_fence(__ATOMIC_RELEASE, "agent"); asm volatile("s_waitcnt vmcnt(0)" ::: "memory");
        (void)__hip_atomic_fetch_add((unsigned*)(F.ctl + CW_SDONE), 1u, RLX_AGENT); }
}
__device__ __forceinline__ bool sample_acquire(Frame& F, bool block) {
    __syncthreads();
    if (F.tid == 0) { unsigned v = __hip_atomic_load((unsigned*)(F.ctl + CW_SDONE), RLX_AGENT);
        if (block) { unsigned sp = 0; while (v < (unsigned)N_SUNITS && sp < (1u << 20)) { __builtin_amdgcn_s_sleep(2); ++sp; v = __hip_atomic_load((unsigned*)(F.ctl + CW_SDONE), RLX_AGENT); } }
        __builtin_amdgcn_fence(__ATOMIC_ACQUIRE, "agent"); asm volatile("s_waitcnt vmcnt(0)" ::: "memory");
        F.MISC[6] = v; }
    __syncthreads();
    return __builtin_amdgcn_readfirstlane((int)F.MISC[6]) >= N_SUNITS;
}

struct Args { const float* in[23]; float* out; unsigned char* ws; int ph_lo, ph_hi; };
__global__ void __launch_bounds__(NWAVES * 64, 2) hymba_fwd(Args args) {
    extern __shared__ __attribute__((aligned(16))) unsigned char lds[];
    Frame F;
    F.lds = (LAS unsigned char*)lds;
    F.MISC = (volatile LAS unsigned*)(F.lds + MISC_OFF);
    F.tid = threadIdx.x; F.lane = F.tid & 63; F.wave = __builtin_amdgcn_readfirstlane(F.tid >> 6);
    F.G = gridDim.x;
    F.ws = args.ws; F.out = args.out;
#pragma unroll
    for (int i = 0; i < 23; ++i) F.in[i] = args.in[i];
    F.ctl = (gu32*)(F.ws + WS_CTL);
    for (int u = F.tid; u < (LDS_BYTES - LDSCTL_OFF) / 4; u += NWAVES * 64) ((LAS unsigned*)(F.lds + LDSCTL_OFF))[u] = 0u;
    __syncthreads();
    const int lo = args.ph_lo, hi = args.ph_hi;
    const bool multi = (hi - lo) > 1;
    XcdBarrier bar; bar.bar = (unsigned*)(F.ctl + CW_BAR); bar.x = 0; bar.st = nullptr;
    if (multi) bar = xcd_barrier_post((unsigned*)(F.ctl + CW_BAR), F.MISC + 8);
#ifdef PH_ONLY
#define IN(k) ((k) == PH_ONLY && lo <= (k) && (k) < hi)
#else
#define IN(k) (lo <= (k) && (k) < hi)
#endif
#define SEAM(k) do { if (IN(k) && IN((k) + 1)) xcd_barrier(bar); } while (0)
    constexpr bool AL = true, SP = true;
#ifndef REP_PH
#define REP_PH -1
#endif
#ifndef REP_PH2
#define REP_PH2 -1
#endif

    const unsigned my_xcc = xb_xcc_id() & 7u;
    if (F.tid == 0) F.MISC[5] = __hip_atomic_fetch_add((unsigned*)(F.ctl + CW_XR + 64 * my_xcc), 1u, RLX_AGENT);
    constexpr int N_P1S = 2 * (NGU / 256);
    constexpr int P0_RA = 11136;
    const bool p1s_in_p0 = F.G >= 4 * N_P1S;
    if (IN(0)) {
        const int bw = (int)blockIdx.x;
        p0_part<0>(F, bw * NWAVES + F.wave, F.G * NWAVES);
        if (p1s_in_p0) {
            ctl_publish(F, CW_P0A);
            if (bw < N_P1S) {
                ctl_acquire(F, CW_P0A, (unsigned)F.G);
                pg8::Gemm g{WSP(bf16, WS_XB), WSP(bf16, WS_WGU1), MT, NGU, D}; pg8::OneUnitOrder S; S.pm = 256 + bw / (NGU / 256); S.pn = bw % (NGU / 256); S.ntk = D / 64; S.has = true;
                pg8::EpiGateUp<false> E{WSP(bf16, WS_ACT), WSP(float, WS_RS), 1.0f};
                pg8::gemm_phase<pg8::EpiGateUp<false>, pg8::OneUnitOrder, AL, SP>(F.lds, g, S, E);
            } else { p0_part<1>(F, (bw - N_P1S) * NWAVES + F.wave, (F.G - N_P1S) * NWAVES); p0_rows(F, 0, P0_RA, (bw - N_P1S) * NWAVES + F.wave, (F.G - N_P1S) * NWAVES); }
            p0_rows(F, P0_RA, MP, bw * NWAVES + F.wave, F.G * NWAVES);
        } else { __syncthreads(); p0_part<1>(F, bw * NWAVES + F.wave, F.G * NWAVES); p0_rows(F, 0, MP, bw * NWAVES + F.wave, F.G * NWAVES); }
        SEAM(0);
    }

    int vc = (int)blockIdx.x;
    if (multi) { bool even = (F.G % 8) == 0;
        unsigned cen[8];
#pragma unroll
        for (int j = 0; j < 8; ++j) cen[j] = __hip_atomic_load((unsigned*)(F.ctl + CW_XR + 64 * j), RLX_AGENT);
#pragma unroll
        for (int j = 0; j < 8; ++j) even = even & (cen[j] == (unsigned)(F.G / 8));
        const int rk = (int)F.MISC[5];
        if (even && rk < F.G / 8) vc = rk * 8 + (int)my_xcc; }
    vc = __builtin_amdgcn_readfirstlane(vc);
    if (IN(1)) {
        pg8::Gemm g{WSP(bf16, WS_XB), WSP(bf16, WS_WGU1), MT, NGU, D}; pg8::StaticOrder S; S.init(p1s_in_p0 ? MP : MT, NGU, F.G, vc, D);
        pg8::EpiGateUp<false> E{WSP(bf16, WS_ACT), WSP(float, WS_RS), 1.0f};
        pg8::gemm_phase<pg8::EpiGateUp<false>, pg8::StaticOrder, AL, SP>(F.lds, g, S, E); SEAM(1);
#if REP_PH == 1 || REP_PH2 == 1
        pg8::gemm_phase<pg8::EpiGateUp<false>, pg8::StaticOrder, AL, SP>(F.lds, g, S, E); SEAM(1);
#endif
#if defined(NULL_PH1)
        { pg8::EpiNull EN; pg8::gemm_phase<pg8::EpiNull, pg8::StaticOrder, AL, SP>(F.lds, g, S, EN); SEAM(1); }
#endif
#if defined(SAME_PH1)
        { pg8::EpiNull EN; pg8::SameTileOrder SS_; SS_.nr = 23; SS_.c = (int)blockIdx.x; SS_.ntk = 16; pg8::gemm_phase<pg8::EpiNull, pg8::SameTileOrder, AL, SP>(F.lds, g, SS_, EN); SEAM(1); }
#endif
    }
    if (IN(2)) {
        pg8::Gemm g{WSP(bf16, WS_ACT), WSP(bf16, WS_WD1), MT, D, FF}; pg8::TailSplitOrder S; S.init(D, F.G, vc, FF, 4);
        typedef pg8::EpiResid<3> E_t; E_t E{nullptr, nullptr, nullptr, WSP(bf16, WS_XB), WSP(float, WS_SS), WSP(float, WS_SLAB), 0.5f, nullptr};
        pg8::gemm_phase<E_t, pg8::TailSplitOrder, AL, SP>(F.lds, g, S, E); xcd_barrier(bar); reduce_tail<3, 11>(F, 0.5f); SEAM(2);
#if REP_PH == 2 || REP_PH2 == 2
        pg8::gemm_phase<E_t, pg8::TailSplitOrder, AL, SP>(F.lds, g, S, E); xcd_barrier(bar); reduce_tail<3, 11>(F, 0.5f); SEAM(2);
#endif
#if defined(NULL_PH2)
        { pg8::EpiNull EN; pg8::gemm_phase<pg8::EpiNull, pg8::TailSplitOrder, AL, SP>(F.lds, g, S, EN); SEAM(2); }
#endif
    }
    if (IN(3)) {
        pg8::Gemm g{WSP(bf16, WS_XB), WSP(bf16, WS_WIN), MT, INP, D}; pg8::StaticOrder S; S.init(MP, INP, F.G, vc, D);
        pg8::EpiIn<0> E{WSP(float, WS_RS), WSP(float, WS_ROPE), F.in[13], F.in[14], F.in[15], F.in[16],
                     WSP(bf16, WS_Q), WSP(bf16, WS_K), WSP(bf16, WS_V), WSP(bf16, WS_MQ), WSP(bf16, WS_MK), WSP(bf16, WS_MV), WSP(bf16, WS_MO), WSP(float, WS_G),
                     F.out + O_KP, F.out + O_VP, F.out + O_KS, F.out + O_VS};
#if defined(P3_ONE_CALL)
        pg8::gemm_phase<pg8::EpiIn<0>, pg8::StaticOrder, AL, SP>(F.lds, g, S, E); SEAM(3);
#else
        {
            { pg8::OffsetOrder S2; S2.init(MP, 10, 4, F.G, vc, D);
              pg8::EpiIn<0, 2> E2{E.SS, E.rope, E.qg, E.kg, E.big, E.bfg, E.Q, E.K, E.V, E.MQ, E.MK, E.MV, E.MO, E.G, E.KoP, E.VoP, E.KoS, E.VoS};
              pg8::gemm_phase<pg8::EpiIn<0, 2>, pg8::OffsetOrder, AL, SP>(F.lds, g, S2, E2); }
            { pg8::OffsetOrder S1; S1.init(MP, 4, 0, F.G, vc, D);
              pg8::EpiIn<0, 1> E1{E.SS, E.rope, E.qg, E.kg, E.big, E.bfg, E.Q, E.K, E.V, E.MQ, E.MK, E.MV, E.MO, E.G, E.KoP, E.VoP, E.KoS, E.VoS};
              pg8::gemm_phase<pg8::EpiIn<0, 1>, pg8::OffsetOrder, AL, SP>(F.lds, g, S1, E1); }
            { pg8::OffsetOrder S3; S3.init(MP, 1, 14, F.G, vc, D);
              pg8::EpiIn<0, 3> E3{E.SS, E.rope, E.qg, E.kg, E.big, E.bfg, E.Q, E.K, E.V, E.MQ, E.MK, E.MV, E.MO, E.G, E.KoP, E.VoP, E.KoS, E.VoS};
              pg8::gemm_phase<pg8::EpiIn<0, 3>, pg8::OffsetOrder, AL, SP>(F.lds, g, S3, E3); }
            SEAM(3); }
#endif
#if defined(NULL_PH3)
        { pg8::EpiNull EN; pg8::gemm_phase<pg8::EpiNull, pg8::StaticOrder, AL, SP>(F.lds, g, S, EN); SEAM(3); }
#endif
#if defined(VAR_PH3)
        { pg8::EpiIn<VAR_PH3> EV{E.SS, E.rope, E.qg, E.kg, E.big, E.bfg, E.Q, E.K, E.V, E.MQ, E.MK, E.MV, E.MO, E.G, E.KoP, E.VoP, E.KoS, E.VoS}; pg8::gemm_phase<pg8::EpiIn<VAR_PH3>, pg8::StaticOrder, AL, SP>(F.lds, g, S, EV); SEAM(3); }
#endif
#if REP_PH == 3 || REP_PH2 == 3
        pg8::gemm_phase<pg8::EpiIn<0>, pg8::StaticOrder, AL, SP>(F.lds, g, S, E); SEAM(3);
#endif
    }
    if (IN(4)) {
#ifndef REP_SUB
#define REP_SUB 0
#endif
#define MIX4A(qb) for (;;) { const int idx = queue_next(F, qb); if (idx >= U4_ML1) break; mlstm1_unit(F, idx); }
#define MIX4B(qb) for (;;) { const int idx = queue_next(F, qb + 64); if (idx >= U4_SATT) break; sattn_unit(F, idx); }
#define MIX4C(qb) for (;;) { const int idx = queue_next(F, qb + 128); if (idx >= U4_SML) break; smlstm_unit(F, idx); }
#define MIX4D(qb) for (;;) { const int idx = queue_next(F, qb + 192); if (idx >= U4_ATT) break; attn_seq_unit<false>(F, idx >> 4, (idx >> 1) & 7, idx & 1); }
#define MIX4(qb) MIX4A(qb) if (blockIdx.x & 1) { MIX4B(qb) MIX4C(qb) } MIX4D(qb) if (!(blockIdx.x & 1)) { MIX4B(qb) MIX4C(qb) }
#if REP_SUB == 1
        MIX4A(CW_Q4 + 2048) xcd_barrier(bar);
#elif REP_SUB == 2
        MIX4B(CW_Q4 + 2048) xcd_barrier(bar);
#elif REP_SUB == 3
        MIX4C(CW_Q4 + 2048) xcd_barrier(bar);
#elif REP_SUB == 4
        MIX4D(CW_Q4 + 2048) xcd_barrier(bar);
#elif REP_SUB == 41 || REP_SUB == 42 || REP_SUB == 44 || REP_SUB == 45
        for (;;) { const int idx = queue_next(F, CW_Q4 + 2048 + 192); if (idx >= U4_ATT) break; attn_seq_unit<false, REP_SUB - 40>(F, idx >> 4, (idx >> 1) & 7, idx & 1); } xcd_barrier(bar);
#endif
        {
            const int j = (int)blockIdx.x;
            if (j < N_SUNITS) {
                pg8::Gemm g{WSP(bf16, WS_XB), WSP(bf16, WS_WIN), MT, INP, D}; pg8::OneUnitOrder S1{256 + j / (INP / 256), j % (INP / 256), D / 64, true};
                pg8::EpiIn<0> E{WSP(float, WS_RS), WSP(float, WS_ROPE), F.in[13], F.in[14], F.in[15], F.in[16],
                             WSP(bf16, WS_Q), WSP(bf16, WS_K), WSP(bf16, WS_V), WSP(bf16, WS_MQ), WSP(bf16, WS_MK), WSP(bf16, WS_MV), WSP(bf16, WS_MO), WSP(float, WS_G),
                             F.out + O_KP, F.out + O_VP, F.out + O_KS, F.out + O_VS};
                pg8::gemm_phase<pg8::EpiIn<0>, pg8::OneUnitOrder, AL, SP>(F.lds, g, S1, E);
                sample_publish(F);
            }
        }
        MIX4A(CW_Q4)
        {   bool early = false;
            if (blockIdx.x & 1) { early = sample_acquire(F, false); if (early) { MIX4B(CW_Q4) MIX4C(CW_Q4) } }
            MIX4D(CW_Q4)
            if (!early) { (void)sample_acquire(F, true); MIX4B(CW_Q4) MIX4C(CW_Q4) } }
#if REP_PH == 4 || REP_PH2 == 4
        xcd_barrier(bar); MIX4(CW_Q4 + 1024)
#endif
        SEAM(4);
    }
    if (IN(5)) {
#define MIX5A(qb) mlstm2_seq(F, (int)blockIdx.x, F.G, U5_ML2);
#define MIX5B(qb) for (int idx = (int)blockIdx.x; idx < U5_ATT; idx += F.G) attn_seq_unit<true>(F, idx >> 3, idx & 7, 2);
#define MIX5(qb) MIX5A(qb) MIX5B(qb)
#if REP_SUB == 5
        MIX5A(CW_Q5 + 2048) xcd_barrier(bar);
#elif REP_SUB == 6
        MIX5B(CW_Q5 + 2048) xcd_barrier(bar);
#elif REP_SUB == 63
        for (;;) { const int idx = queue_next(F, CW_Q5 + 2048 + 64); if (idx >= U5_ATT) break; attn_seq_unit<true, 3>(F, idx >> 3, idx & 7, 2); } xcd_barrier(bar);
#endif
        MIX5(CW_Q5)
#if REP_PH == 5 || REP_PH2 == 5
        xcd_barrier(bar); MIX5(CW_Q5 + 1024)
#endif
        SEAM(5);
    }
    if (IN(6)) {
        pg8::Gemm g{WSP(bf16, WS_MIX), WSP(bf16, WS_WOUT), MT, D, D}; pg8::TailSplitOrder S; S.init(D, F.G, vc, D, 4);
        typedef pg8::EpiResid<1> E_t; E_t E{nullptr, nullptr, nullptr, WSP(bf16, WS_XB), WSP(float, WS_SS), WSP(float, WS_SLAB), 1.0f, WSP(unsigned char, WS_X8)};
        pg8::gemm_phase<E_t, pg8::TailSplitOrder, AL, SP>(F.lds, g, S, E); xcd_barrier(bar); reduce_tail<1, 4>(F, 1.0f);
        SEAM(6);
    }
    if (IN(7)) {
        pg8::Gemm g{WSP(bf16, WS_X8), WSP(bf16, WS_WGU2), MT, NGU, D / 2}; pg8::StaticOrder S; S.init(MT, NGU, F.G, vc, D / 2);
        pg8::EpiGateUp<true> E{WSP(bf16, WS_ACT), WSP(float, WS_RS), 1.0f / 512.f};
        pg8::gemm_phase<pg8::EpiGateUp<true>, pg8::StaticOrder, AL, SP, true>(F.lds, g, S, E); SEAM(7);
#if REP_PH == 7 || REP_PH2 == 7
        pg8::gemm_phase<pg8::EpiGateUp<true>, pg8::StaticOrder, AL, SP, true>(F.lds, g, S, E); SEAM(7);
#endif
    }
    if (IN(8)) {
        pg8::Gemm g{WSP(bf16, WS_ACT), WSP(bf16, WS_WD2), MT, D, FF / 2}; pg8::TailSplitOrder S; S.init(D, F.G, vc, FF / 2, 4);
        typedef pg8::EpiResid<2> E_t; E_t E{nullptr, nullptr, F.out + O_Y, WSP(bf16, WS_XB), nullptr, WSP(float, WS_SLAB), 0.5f / 512.f, nullptr};
        pg8::gemm_phase<E_t, pg8::TailSplitOrder, AL, SP, true>(F.lds, g, S, E); xcd_barrier(bar); reduce_tail<2, 5>(F, 0.5f / 512.f);
    }
#undef IN
#undef SEAM
}

extern "C" void kernel_launch(void* const* d_in, const int* in_sizes, int n_in, void* d_out, int out_size, void* d_ws, size_t ws_size, hipStream_t stream) {
    static int grid = 0;
    if (grid == 0) {
        if (n_in != 23 || in_sizes[0] != MP * D || (size_t)out_size != O_END || ws_size < WS_END) {
            fprintf(stderr, "kernel_launch: unexpected shapes (n_in %d, in0 %d, out %d, ws %zu; need ws >= %zu); nothing launched\n", n_in, n_in > 0 ? in_sizes[0] : -1, out_size, ws_size, (size_t)WS_END); grid = -1; return; }
        int dev = 0, cus = 0, per_cu = 0;
        if (hipGetDevice(&dev) != hipSuccess || hipDeviceGetAttribute(&cus, hipDeviceAttributeMultiprocessorCount, dev) != hipSuccess) { fprintf(stderr, "kernel_launch: device query failed\n"); grid = -1; return; }
        if (hipFuncSetAttribute((const void*)hymba_fwd, hipFuncAttributeMaxDynamicSharedMemorySize, LDS_BYTES) != hipSuccess) { fprintf(stderr, "kernel_launch: hipFuncSetAttribute failed\n"); grid = -1; return; }
        if (hipOccupancyMaxActiveBlocksPerMultiprocessor(&per_cu, (const void*)hymba_fwd, NWAVES * 64, LDS_BYTES) != hipSuccess || per_cu < 1)
            fprintf(stderr, "kernel_launch: note: occupancy query reports %d workgroups per CU\n", per_cu);
        (void)hipGetLastError();
        grid = cus;
    }
    if (grid < 0) return;
    if (hipMemsetAsync((char*)d_ws + WS_CTL, 0, CTL_ZERO_BYTES, stream) != hipSuccess) { fprintf(stderr, "kernel_launch: memset failed\n"); return; }
    Args a{};
    for (int i = 0; i < 23; ++i) a.in[i] = (const float*)d_in[i];
    a.out = (float*)d_out; a.ws = (unsigned char*)d_ws;
#if MK_N_LAUNCHES == 1
    a.ph_lo = 0; a.ph_hi = N_PHASES;
    hipLaunchKernelGGL(hymba_fwd, dim3(grid), dim3(NWAVES * 64), LDS_BYTES, stream, a);
#else
    for (int p = 0; p < N_PHASES; ++p) { a.ph_lo = p; a.ph_hi = p + 1; hipLaunchKernelGGL(hymba_fwd, dim3(grid), dim3(NWAVES * 64), LDS_BYTES, stream, a); }
#endif
    const hipError_t le = hipPeekAtLastError();
    if (le != hipSuccess) fprintf(stderr, "kernel_launch: launch failed: %s\n", hipGetErrorName(le));
}
```

```cpp
#include <hip/hip_runtime.h>
#include <cstdio>
#include <cstdint>

#ifndef MK_N_LAUNCHES
#define MK_N_LAUNCHES 1
#endif

constexpr int D = 1024, SEQ = 2048, NB = 32, MP = NB * SEQ;
constexpr int DECB = 128, DECS = 4, MS = DECB * DECS, MT = MP + MS;
constexpr int FF = 2816, NGU = 2 * FF;
constexpr int NATT = 8, HD = 64, ATTW = 512, NMLH = 4, DK = 128;
constexpr int INW = 3592, INP = 3840;
constexpr int PAST = 8192, WINB = 2048;
constexpr float EPS = 1e-6f;
constexpr float QSCALE = 0.125f * 1.4426950408889634f;
constexpr int NROPE = SEQ + DECS;


__host__ __device__ __forceinline__ size_t att_idx(size_t row, int head) { return row < (size_t)MP ? ((((row >> 11) * 8 + head) << 11) + (row & 2047)) * 64 : row * 512 + (size_t)head * 64; }
__host__ __device__ __forceinline__ size_t ml_idx(size_t row, int head) { return row * 512 + (size_t)head * 128; }

constexpr size_t O_Y = 0;
constexpr size_t O_KP = (size_t)MT * D;
constexpr size_t O_VP = O_KP + (size_t)MP * ATTW;
constexpr size_t O_KS = O_VP + (size_t)MP * ATTW;
constexpr size_t O_VS = O_KS + (size_t)MS * ATTW;
constexpr size_t O_CP = O_VS + (size_t)MS * ATTW;
constexpr size_t O_NP = O_CP + (size_t)NB * NMLH * DK * DK;
constexpr size_t O_MP = O_NP + (size_t)NB * NMLH * DK;
constexpr size_t O_CS = O_MP + (size_t)NB * NMLH;
constexpr size_t O_NS = O_CS + (size_t)DECB * NMLH * DK * DK;
constexpr size_t O_MS = O_NS + (size_t)DECB * NMLH * DK;
constexpr size_t O_END = O_MS + (size_t)DECB * NMLH;
static_assert(O_END == 145834624ull, "d_out map");

constexpr size_t MiB = 1u << 20;
constexpr size_t WS_CTL = 0, CTL_ZERO_BYTES = 1 * MiB;
constexpr size_t WS_WGU1 = 1 * MiB;
constexpr size_t WS_WD1 = WS_WGU1 + (size_t)NGU * D * 2;
constexpr size_t WS_WIN = WS_WD1 + (size_t)D * FF * 2;
constexpr size_t WS_WOUT = WS_WIN + (size_t)INP * D * 2;
constexpr size_t WS_WGU2 = WS_WOUT + (size_t)D * D * 2;
constexpr size_t WS_WD2 = WS_WGU2 + (size_t)NGU * D * 2;
constexpr size_t WS_ROPE = WS_WD2 + (size_t)D * FF * 2;
constexpr size_t WS_XB = 64 * MiB;
constexpr size_t WS_SS = WS_XB + (size_t)MT * D * 2;
constexpr size_t WS_ACT = WS_SS + (size_t)MT * 16 * 4;
constexpr size_t WS_Q = WS_ACT + (size_t)MT * FF * 2;
constexpr size_t SZ_H = (size_t)MT * ATTW * 2;
constexpr size_t WS_K = WS_Q + SZ_H, WS_V = WS_K + SZ_H, WS_MQ = WS_V + SZ_H, WS_MK = WS_MQ + SZ_H, WS_MV = WS_MK + SZ_H, WS_MO = WS_MV + SZ_H;
constexpr size_t WS_G = WS_MO + SZ_H;
constexpr size_t WS_MIX = WS_G + (size_t)MT * 8 * 4;
constexpr size_t WS_OP = WS_MIX + (size_t)MT * D * 2;
constexpr size_t WS_LSE = WS_OP + 2 * (size_t)MP * ATTW * 2;
constexpr size_t WS_CT = WS_LSE + 2 * (size_t)MP * 8 * 4;
constexpr size_t WS_NC = WS_CT + (size_t)128 * 16 * DK * DK * 2;
constexpr size_t WS_MC = WS_NC + (size_t)128 * 16 * DK * 4;
constexpr size_t WS_SLAB = WS_MC + (size_t)128 * 16 * 4;
constexpr size_t WS_RS = WS_SLAB + (size_t)11 * 512 * 1024 * 4;
constexpr size_t WS_X8 = WS_RS + (size_t)MT * 4 + 256;
constexpr size_t WS_END = WS_X8 + (size_t)MT * D;
static_assert(WS_ROPE + (size_t)NROPE * 64 * 4 <= WS_XB, "weights fit below XB");
static_assert(WS_END < 1800 * MiB, "workspace");
static_assert(WS_XB % 256 == 0 && WS_SS % 256 == 0 && WS_ACT % 256 == 0 && WS_Q % 256 == 0 && SZ_H % 256 == 0 && WS_G % 256 == 0 && WS_MIX % 256 == 0 && WS_OP % 256 == 0 && WS_LSE % 256 == 0 && WS_CT % 256 == 0 && WS_NC % 256 == 0 && WS_MC % 256 == 0 && WS_SLAB % 256 == 0 && WS_X8 % 256 == 0, "alignment");

constexpr int CW_Q4 = 64, CW_Q5 = 512;
constexpr int CW_XR = 8192;
constexpr int CW_P0A = 3648;
constexpr int CW_SDONE = 3584;
constexpr int CW_BAR = 4096;

constexpr int NWAVES = 8;
constexpr int RING_BYTES = 131072;
constexpr int MISC_OFF = RING_BYTES + 320;
constexpr int LDSCTL_OFF = RING_BYTES;
constexpr int LDS_BYTES = 147456;

#define GAS __attribute__((address_space(1)))
#define LAS __attribute__((address_space(3)))
namespace pg8 {
#define PG8_LAS __attribute__((address_space(3)))
typedef unsigned short bf16_t;
typedef short bf16x8 __attribute__((ext_vector_type(8)));
typedef float f32x4 __attribute__((ext_vector_type(4)));
typedef unsigned u32x4 __attribute__((ext_vector_type(4)));
typedef int v8i32 __attribute__((ext_vector_type(8)));
typedef double v2d_ __attribute__((ext_vector_type(2)));
constexpr int BM = 256, BK = 64, HALF = 128, HTB = HALF * BK * 2  , STAGE_BYTES = 8 * HTB, NXCD = 8, WGM = 8;

__host__ __device__ __forceinline__ int lds_byte(int r, int c) { const int st = (r >> 4) * 2 + (c >> 5), rr = r & 15, cc = c & 31, ob = rr * 64 + cc * 2; return st * 1024 + (ob ^ (((ob >> 9) & 1) << 5)); }
__host__ __device__ __forceinline__ void stage_rc(int b, int& R, int& C) { const int st = b / 1024, sb = b % 1024, swz = sb ^ (((sb >> 9) & 1) << 5); R = (st >> 1) * 16 + swz / 64; C = (st & 1) * 32 + (swz % 64) / 2; }
__host__ __device__ __forceinline__ int perm32(int rho) { const int n = rho >> 4, i = rho & 15; return 8 * (i >> 2) + 4 * n + (i & 3); }

struct Unit { int pm, pn, k0, nk, slab; };
struct Gemm { const bf16_t* A; const bf16_t* Bt; int M, N, K; };

struct StaticOrder {
    int nM, nN, nwg, G, c, ntk;
    __host__ __device__ void init(int M, int N, int G_, int c_, int K_) { nM = M / BM; nN = N / BM; nwg = nM * nN; G = G_; c = c_; ntk = K_ / BK; }
    __host__ __device__ bool next(int i, Unit& u) const {
        const long L = (long)i * G + c; if (L >= nwg) return false;
        int wgid = (int)L; { const int q = nwg / NXCD, r = nwg % NXCD, xcd = wgid % NXCD, off = wgid / NXCD; wgid = (xcd < r ? xcd * (q + 1) : r * (q + 1) + (xcd - r) * q) + off; }
        const int nig = WGM * nN, gid = wgid / nig, fm = gid * WGM, gsz = (nM - fm) < WGM ? (nM - fm) : WGM;
        u.pm = fm + ((wgid % nig) % gsz); u.pn = (wgid % nig) / gsz; u.k0 = 0; u.nk = ntk; u.slab = -1; return true;
    }
    __device__ __forceinline__ void a_ready(const Unit&) const {}
    __device__ __forceinline__ void done(const Unit&) const {}
};
struct TailSplitOrder {
    StaticOrder P; int nN, nS, nkS, ntk, G, c, nP;
    __host__ __device__ void init(int N, int G_, int c_, int K_, int nkS_) { P.init(65536, N, G_, c_, K_); nN = N / BM; nkS = nkS_; ntk = K_ / BK; nS = ntk / nkS_; G = G_; c = c_; nP = P.nwg; }
    __host__ __device__ bool next(int i, Unit& u) const {
        const long L = (long)i * G + c; if (L < nP) return P.next(i, u);
        const int j = (int)(L - nP); if (j >= 2 * nN * nS) return false;
        const int ks = j % nS, t = j / nS; u.pm = 256 + t / nN; u.pn = t % nN; u.k0 = ks * nkS; u.nk = (ks == nS - 1) ? ntk - ks * nkS : nkS; u.slab = ks; return true;
    }
    __device__ __forceinline__ void a_ready(const Unit&) const {}
    __device__ __forceinline__ void done(const Unit&) const {}
};
struct SameTileOrder {
    int nr, c, ntk;
    __host__ __device__ bool next(int i, Unit& u) const { if (i >= nr) return false; u.pm = c & 7; u.pn = (c >> 3) & 3; u.k0 = 0; u.nk = ntk; u.slab = -1; return true; }
    __device__ __forceinline__ void a_ready(const Unit&) const {}
    __device__ __forceinline__ void done(const Unit&) const {}
};
struct OneUnitOrder {
    int pm, pn, ntk; bool has;
    __host__ __device__ bool next(int i, Unit& u) const { if (i != 0 || !has) return false; u.pm = pm; u.pn = pn; u.k0 = 0; u.nk = ntk; u.slab = -1; return true; }
    __device__ __forceinline__ void a_ready(const Unit&) const {}
    __device__ __forceinline__ void done(const Unit&) const {}
};
struct OffsetOrder {
    StaticOrder P; int n0;
    __host__ __device__ void init(int M, int nn, int n0_, int G_, int c_, int K_, int last_to_ = -1) { P.init(M, nn * BM, G_, c_, K_); n0 = n0_; last_to = last_to_; }
    int last_to;
    __host__ __device__ bool next(int i, Unit& u) const { if (!P.next(i, u)) return false; u.pn = (last_to >= 0 && u.pn == P.nN - 1) ? last_to : u.pn + n0; return true; }
    __device__ __forceinline__ void a_ready(const Unit&) const {}
    __device__ __forceinline__ void done(const Unit&) const {}
};

typedef __bf16 bf16x2_t __attribute__((ext_vector_type(2)));
typedef float f32x2_t __attribute__((ext_vector_type(2)));
__device__ __forceinline__ unsigned pk2(float lo, float hi) { f32x2_t v = {lo, hi}; bf16x2_t b = __builtin_convertvector(v, bf16x2_t); return __builtin_bit_cast(unsigned, b); }
__device__ __forceinline__ u32x4 pk8(f32x4 a, f32x4 b) { u32x4 w; w.x = pk2(a[0], a[1]); w.y = pk2(a[2], a[3]); w.z = pk2(b[0], b[1]); w.w = pk2(b[2], b[3]); return w; }
__device__ __forceinline__ float row_rs(const float* RS, int row) { return RS[row]; }
typedef unsigned u32x2_ __attribute__((ext_vector_type(2)));
__device__ __forceinline__ float clamp_fp8(float x, float scale) { return __builtin_amdgcn_fmed3f(x * scale, -448.f, 448.f); }
__device__ __forceinline__ u32x2_ pk8_fp8(const f32x4 a, const f32x4 b, const float scale) {
    int w0 = 0, w1 = 0;
    w0 = __builtin_amdgcn_cvt_pk_fp8_f32(clamp_fp8(a[0], scale), clamp_fp8(a[1], scale), w0, false); w0 = __builtin_amdgcn_cvt_pk_fp8_f32(clamp_fp8(a[2], scale), clamp_fp8(a[3], scale), w0, true);
    w1 = __builtin_amdgcn_cvt_pk_fp8_f32(clamp_fp8(b[0], scale), clamp_fp8(b[1], scale), w1, false); w1 = __builtin_amdgcn_cvt_pk_fp8_f32(clamp_fp8(b[2], scale), clamp_fp8(b[3], scale), w1, true);
    return (u32x2_){(unsigned)w0, (unsigned)w1};
}
__device__ __forceinline__ float silu_f(float x) { return x * __builtin_amdgcn_rcpf(1.f + __builtin_amdgcn_exp2f(-1.4426950408889634f * x)); }
__device__ __forceinline__ float sigmoid_f(float x) { return __builtin_amdgcn_rcpf(1.f + __builtin_amdgcn_exp2f(-1.4426950408889634f * x)); }

template <bool F8> struct EpiGateUp {
    static constexpr bool PERM = true, AFTER_DRAIN = false;
    bf16_t* ACT; const float* SS; float isc;
    __device__ __forceinline__ void operator()(const f32x4 (&acc)[2][2][4][2], const Unit& u, int wr, int wc, int fr, int fq) const {
        const int row0 = u.pm * BM + wr * 64 + fr, col0 = u.pn * 128 + wc * 32 + 8 * fq;
        float rsv[2][4];
#pragma unroll
        for (int ai = 0; ai < 2; ++ai)
#pragma unroll
            for (int m = 0; m < 4; ++m) rsv[ai][m] = row_rs(SS, row0 + ai * HALF + m * 16) * isc;
#pragma unroll
        for (int ai = 0; ai < 2; ++ai)
#pragma unroll
            for (int m = 0; m < 4; ++m) { const int row = row0 + ai * HALF + m * 16; const float rs = rsv[ai][m]; const float nrs = -1.4426950408889634f * rs, rs2 = rs * rs;
                f32x4 o[2];
#pragma unroll
                for (int n = 0; n < 2; ++n) { const f32x4 t = acc[ai][0][m][n] * nrs, gu = acc[ai][0][m][n] * acc[ai][1][m][n] * rs2;
#pragma unroll
                    for (int i = 0; i < 4; ++i) o[n][i] = gu[i] * __builtin_amdgcn_rcpf(1.f + __builtin_amdgcn_exp2f(t[i])); }
                if (F8) *(u32x2_*)((unsigned char*)ACT + (size_t)row * 2816 + col0) = pk8_fp8(o[0], o[1], 8.f);
                else *(u32x4*)(ACT + (size_t)row * 2816 + col0) = pk8(o[0], o[1]); }
    }
};

template <int MODE> struct EpiResid {
    static constexpr bool PERM = true, AFTER_DRAIN = false;
    const float* resP; const float* resS;
    float* Y; bf16_t* XB; float* SS; float* SLAB; float alpha; unsigned char* X8;
    __device__ __forceinline__ void operator()(const f32x4 (&acc)[2][2][4][2], const Unit& u, int wr, int wc, int fr, int fq) const {
        const int row0 = u.pm * BM + wr * 64 + fr, col0 = u.pn * BM + wc * 32 + 8 * fq;
        const float* const resP_ = resP; const float* const resS_ = resS; float* const Y_ = Y; bf16_t* const XB_ = XB; float* const SS_ = SS; float* const SLAB_ = SLAB; const float alpha_ = alpha; unsigned char* const X8_ = X8;
        const int upm = u.pm, upn = u.pn;
        if (u.slab >= 0) {
#pragma unroll
            for (int ai = 0; ai < 2; ++ai)
#pragma unroll
                for (int m = 0; m < 4; ++m) { bf16_t* sl = (bf16_t*)SLAB_ + ((size_t)u.slab * 512 + (row0 + ai * HALF + m * 16 - 65536)) * 1024 + col0;
#pragma unroll
                    for (int bj = 0; bj < 2; ++bj) *(u32x4*)(sl + bj * HALF) = pk8(acc[ai][bj][m][0], acc[ai][bj][m][1]); }
            return;
        }
        f32x4 nr[2][2];
        auto ldres = [&](int i, f32x4 (&r)[2][2]) { const int row = row0 + (i >> 2) * HALF + (i & 3) * 16;
            const float* rrow = (upm < 256 ? resP_ + (size_t)row * 1024 : resS_ + (size_t)(row - 65536) * 1024);
#pragma unroll
            for (int bj = 0; bj < 2; ++bj) { const int c = col0 + bj * HALF;
                if (MODE == 0) { r[bj][0] = *(const f32x4*)(rrow + c); r[bj][1] = *(const f32x4*)(rrow + c + 4); }
                else { const u32x4 w = *(const u32x4*)(XB_ + (size_t)row * 1024 + c);
                    r[bj][0] = (f32x4){__builtin_bit_cast(float, w.x << 16), __builtin_bit_cast(float, w.x & 0xffff0000u), __builtin_bit_cast(float, w.y << 16), __builtin_bit_cast(float, w.y & 0xffff0000u)};
                    r[bj][1] = (f32x4){__builtin_bit_cast(float, w.z << 16), __builtin_bit_cast(float, w.z & 0xffff0000u), __builtin_bit_cast(float, w.w << 16), __builtin_bit_cast(float, w.w & 0xffff0000u)}; } } };
        ldres(0, nr);
#pragma unroll
        for (int i = 0; i < 8; ++i) { const int ai = i >> 2, m = i & 3; const int row = row0 + ai * HALF + m * 16;
            f32x4 cr[2][2];
#pragma unroll
            for (int bj = 0; bj < 2; ++bj) { cr[bj][0] = nr[bj][0]; cr[bj][1] = nr[bj][1]; }
            if (i < 7) ldres(i + 1, nr);
            asm volatile("" ::: "memory");
            float ss = 0.f;
#pragma unroll
            for (int bj = 0; bj < 2; ++bj) { const int c = col0 + bj * HALF;
                const f32x4 v0 = cr[bj][0] + acc[ai][bj][m][0] * alpha_, v1 = cr[bj][1] + acc[ai][bj][m][1] * alpha_;
                if (MODE == 2) { *(f32x4*)(Y_ + (size_t)row * 1024 + c) = v0; *(f32x4*)(Y_ + (size_t)row * 1024 + c + 4) = v1; }
                else { *(u32x4*)(XB_ + (size_t)row * 1024 + c) = pk8(v0, v1); if (MODE == 1) *(u32x2_*)(X8_ + (size_t)row * 1024 + c) = pk8_fp8(v0, v1, 16.f);
                    ss += (v0[0] * v0[0] + v0[1] * v0[1]) + (v0[2] * v0[2] + v0[3] * v0[3]) + (v1[0] * v1[0] + v1[1] * v1[1]) + (v1[2] * v1[2] + v1[3] * v1[3]); } }
            if (MODE != 2) { ss += __shfl_xor(ss, 16); ss += __shfl_xor(ss, 32); if (fq == 0) SS_[(size_t)row * 16 + upn * 4 + wc] = ss; } }
    }
};

template <int VAR = 0, int RANGE = 0> struct EpiIn {
    static constexpr bool PERM = true, AFTER_DRAIN = false;
    const float* SS; const float* rope; const float* qg; const float* kg; const float* big; const float* bfg;
    bf16_t *Q, *K, *V, *MQ, *MK, *MV, *MO; float* G; float *KoP, *VoP, *KoS, *VoS;
    __device__ __forceinline__ void operator()(const f32x4 (&acc)[2][2][4][2], const Unit& u, int wr, int wc, int fr, int fq) const {
        const int row0 = u.pm * BM + wr * 64 + fr; const int pn = u.pn; const bool samp = u.pm >= 256;
        float rsv[2][4];
#pragma unroll
        for (int ai = 0; ai < 2; ++ai)
#pragma unroll
            for (int m = 0; m < 4; ++m) rsv[ai][m] = row_rs(SS, row0 + ai * HALF + m * 16);
        if ((RANGE == 0 && pn < 4) || RANGE == 1) {
            const bool isK = pn >= 2; const int head = 4 * (pn & 1) + wc; const float* gain = isK ? kg : qg;
            f32x4 glo[2], ghi[2];
#pragma unroll
            for (int n = 0; n < 2; ++n) { glo[n] = *(const f32x4*)(gain + 8 * fq + 4 * n); ghi[n] = *(const f32x4*)(gain + 32 + 8 * fq + 4 * n); }
            f32x4 ncs[2], nsn[2]; float nrsv;
            auto ldrope = [&](int i) { const int row = row0 + (i >> 2) * HALF + (i & 3) * 16; const int prow = samp ? 2048 + ((row - 65536) & 3) : (row & 2047);
                nrsv = row_rs(SS, row);
                const float* rp = rope + (size_t)prow * 64 + 8 * fq;
#pragma unroll
                for (int n = 0; n < 2; ++n) { ncs[n] = *(const f32x4*)(rp + 4 * n); nsn[n] = *(const f32x4*)(rp + 32 + 4 * n); } };
            ldrope(0);
#pragma unroll
            for (int ai = 0; ai < 2; ++ai)
#pragma unroll
                for (int m = 0; m < 4; ++m) { const int row = row0 + ai * HALF + m * 16; const float rs = nrsv;
                    f32x4 v[2][2]; float ss = 0.f;
#pragma unroll
                    for (int bj = 0; bj < 2; ++bj)
#pragma unroll
                        for (int n = 0; n < 2; ++n) { v[bj][n] = acc[ai][bj][m][n] * rs; ss += (v[bj][n][0] * v[bj][n][0] + v[bj][n][1] * v[bj][n][1]) + (v[bj][n][2] * v[bj][n][2] + v[bj][n][3] * v[bj][n][3]); }
                    ss += __shfl_xor(ss, 16); ss += __shfl_xor(ss, 32);
                    const float inv = __builtin_amdgcn_rsqf(ss * (1.f / 64.f) + 1e-6f);
                    f32x4 ccs[2], csn[2];
#pragma unroll
                    for (int n = 0; n < 2; ++n) { ccs[n] = ncs[n]; csn[n] = nsn[n]; }
                    if (ai * 4 + m < 7) ldrope(ai * 4 + m + 1);
                    asm volatile("" ::: "memory");
                    f32x4 o1[2], o2[2];
#pragma unroll
                    for (int n = 0; n < 2; ++n) { const f32x4 cs = ccs[n], sn = csn[n];
                        const f32x4 x1 = v[0][n] * inv * glo[n], x2 = v[1][n] * inv * ghi[n];
                        o1[n] = x1 * cs - x2 * sn; o2[n] = x1 * sn + x2 * cs; }
                    const size_t e = att_idx((size_t)row, head) + 8 * fq;
                    if (VAR == 2) { asm volatile("" :: "v"(o1[0]), "v"(o1[1]), "v"(o2[0]), "v"(o2[1])); }
                    else if (isK) {
                        if (VAR != 1) { float* ko = samp ? KoS + (size_t)(row - 65536) * 512 : KoP + (size_t)row * 512; ko += head * 64 + 8 * fq;
                        *(f32x4*)(ko) = o1[0]; *(f32x4*)(ko + 4) = o1[1]; *(f32x4*)(ko + 32) = o2[0]; *(f32x4*)(ko + 36) = o2[1]; }
                        *(u32x4*)(K + e) = pk8(o1[0], o1[1]); *(u32x4*)(K + e + 32) = pk8(o2[0], o2[1]);
                    } else {
                        *(u32x4*)(Q + e) = pk8(o1[0] * QSCALE, o1[1] * QSCALE); *(u32x4*)(Q + e + 32) = pk8(o2[0] * QSCALE, o2[1] * QSCALE);
                    } }
        } else if ((RANGE == 0 && pn < 14) || RANGE == 2) {
            const int which = (pn - 4) >> 1;
            bf16_t* dst = which == 0 ? V : which == 1 ? MQ : which == 2 ? MK : which == 3 ? MV : MO;
            const float sc = which == 2 ? 0.08838834764831845f : 1.f;
            const int col0 = (pn & 1) * 256 + wc * 32 + 8 * fq;
#pragma unroll
            for (int ai = 0; ai < 2; ++ai)
#pragma unroll
                for (int m = 0; m < 4; ++m) { const int row = row0 + ai * HALF + m * 16; const float rs = rsv[ai][m] * sc;
#pragma unroll
                    for (int bj = 0; bj < 2; ++bj) { f32x4 v0 = acc[ai][bj][m][0] * rs, v1 = acc[ai][bj][m][1] * rs; const int c = col0 + bj * HALF;
                        if (VAR == 2) { asm volatile("" :: "v"(v0), "v"(v1)); continue; }
                        if (which == 0 && VAR != 1) { float* vo = samp ? VoS + (size_t)(row - 65536) * 512 : VoP + (size_t)row * 512; *(f32x4*)(vo + c) = v0; *(f32x4*)(vo + c + 4) = v1; }
                        if (which == 4) {
#pragma unroll
                            for (int i = 0; i < 4; ++i) { v0[i] = sigmoid_f(v0[i]); v1[i] = sigmoid_f(v1[i]); } }
                        *(u32x4*)(dst + (which == 0 ? att_idx((size_t)row, c >> 6) + (c & 63) : ml_idx((size_t)row, c >> 7) + (c & 127))) = pk8(v0, v1); } }
        } else {
            if (wc == 0) {
                const f32x4 bi = *(const f32x4*)big, bf = *(const f32x4*)bfg;
#pragma unroll
                for (int ai = 0; ai < 2; ++ai)
#pragma unroll
                    for (int m = 0; m < 4; ++m) { const int row = row0 + ai * HALF + m * 16; const float rs = rsv[ai][m];
                        const f32x4 ig = acc[ai][0][m][0] * rs + bi; const f32x4 x = acc[ai][0][m][1] * rs + bf; f32x4 lf;
#pragma unroll
                        for (int i = 0; i < 4; ++i) lf[i] = fminf(x[i], 0.f) - 0.6931471805599453f * __builtin_amdgcn_logf(1.f + __builtin_amdgcn_exp2f(-1.4426950408889634f * fabsf(x[i])));
                        if (fq == 0) { *(f32x4*)(G + (size_t)row * 8) = ig; *(f32x4*)(G + (size_t)row * 8 + 4) = lf; } }
            }
        }
    }
};

struct EpiNull {
    static constexpr bool PERM = true, AFTER_DRAIN = false;
    __device__ __forceinline__ void operator()(const f32x4 (&acc)[2][2][4][2], const Unit& u, int wr, int wc, int fr, int fq) const {
#pragma unroll
        for (int ai = 0; ai < 2; ++ai)
#pragma unroll
            for (int bj = 0; bj < 2; ++bj)
#pragma unroll
                for (int m = 0; m < 4; ++m)
#pragma unroll
                    for (int n = 0; n < 2; ++n) asm volatile("" :: "v"(acc[ai][bj][m][n]));
    }
};
template <class Epi, class Sched, bool ALIGN_EPI = false, bool SP2 = false, bool FP8 = false>
__device__ __forceinline__ void gemm_phase(PG8_LAS unsigned char* lds, const Gemm g, const Sched& S, const Epi& E) {
    const int tid = threadIdx.x, wid = __builtin_amdgcn_readfirstlane(tid >> 6), lane = tid & 63, wr = wid >> 2, wc = wid & 3, fr = lane & 15, fq = lane >> 4;
    const int K = g.K;
    const int one_scale = 0x7f7f7f7f;
    unsigned voffA[2], voffB[2];
#pragma unroll
    for (int i = 0; i < 2; ++i) { int R, C; stage_rc(tid * 16 + i * 8192, R, C); const int Rb = Epi::PERM ? ((R & ~31) + perm32(R & 31)) : R;
        voffA[i] = (unsigned)(R * K + C) * 2u; voffB[i] = (unsigned)(Rb * K + C) * 2u; }
    const size_t kstep = (size_t)(BK * 2);
    const size_t hstep = (size_t)HALF * K * 2;
    const size_t tstep = 2 * hstep;
    const unsigned ldsw = (unsigned)wid * 1024u;
    const int aoff = lds_byte(wr * 64 + fr, fq * 8), boff = lds_byte(wc * 32 + fr, fq * 8);
#define PG8_SA(b, h) (((b) * 2 + (h)) * HTB)
#define PG8_SB(b, h) ((4 + (b) * 2 + (h)) * HTB)
    const unsigned ldsb = (unsigned)__builtin_amdgcn_readfirstlane((int)(unsigned)(size_t)lds) + ldsw;
#define PG8_STAGE(bufoff, gbase, voff) do { _Pragma("unroll") for (int _i = 0; _i < 2; ++_i) { \
        const char* gp_ = (const char*)(gbase) + (voff)[_i]; const unsigned ld_ = ldsb + (unsigned)((bufoff) + _i * 8192); unsigned keep_; \
        asm volatile("s_mov_b32 %0, m0\n\ts_mov_b32 m0, %2\n\ts_nop 0\n\tglobal_load_lds_dwordx4 %1, off\n\ts_mov_b32 m0, %0" : "=&s"(keep_) : "v"(gp_), "s"(ld_) : "memory"); } } while (0)
#define PG8_LDA(dst, b, h) do { _Pragma("unroll") for (int m = 0; m < 4; ++m) _Pragma("unroll") for (int k = 0; k < 2; ++k) dst[m][k] = *(const PG8_LAS bf16x8*)(lds + PG8_SA(b, h) + aoff + m * 2048 + k * 1024); } while (0)
#define PG8_LDB(dst, b, h) do { _Pragma("unroll") for (int n = 0; n < 2; ++n) _Pragma("unroll") for (int k = 0; k < 2; ++k) dst[n][k] = *(const PG8_LAS bf16x8*)(lds + PG8_SB(b, h) + boff + n * 2048 + k * 1024); } while (0)
#define PG8_MMA(ai, bj, At, Bt) do { __builtin_amdgcn_s_setprio(1); \
        if constexpr (FP8) { _Pragma("unroll") for (int m = 0; m < 4; ++m) _Pragma("unroll") for (int n = 0; n < 2; ++n) { \
            const v8i32 fa_ = __builtin_bit_cast(v8i32, __builtin_shufflevector(Bt[n][0], Bt[n][1], 0, 1, 2, 3, 4, 5, 6, 7, 8, 9, 10, 11, 12, 13, 14, 15)); \
            const v8i32 fb_ = __builtin_bit_cast(v8i32, __builtin_shufflevector(At[m][0], At[m][1], 0, 1, 2, 3, 4, 5, 6, 7, 8, 9, 10, 11, 12, 13, 14, 15)); \
            asm volatile("s_nop 1\n\tv_mfma_scale_f32_16x16x128_f8f6f4 %0, %1, %2, %0, %3, %3 op_sel_hi:[0,0,0]" : "+v"(acc[ai][bj][m][n]) : "v"(fa_), "v"(fb_), "v"(one_scale)); } } \
        else { _Pragma("unroll") for (int m = 0; m < 4; ++m) _Pragma("unroll") for (int n = 0; n < 2; ++n) _Pragma("unroll") for (int k = 0; k < 2; ++k) \
            acc[ai][bj][m][n] = __builtin_amdgcn_mfma_f32_16x16x32_bf16(Bt[n][k], At[m][k], acc[ai][bj][m][n], 0, 0, 0); } \
        __builtin_amdgcn_s_setprio(0); } while (0)
#define PG8_WAIT_V(n) asm volatile("s_waitcnt vmcnt(" #n ")" ::: "memory")
#define PG8_WAIT_L(n) asm volatile("s_waitcnt lgkmcnt(" #n ")" ::: "memory")
#define PG8_BAR __builtin_amdgcn_s_barrier()
#define PG8_SCHED __builtin_amdgcn_sched_barrier(0)
    Unit cur, nxt; int ui = 0;
    if (!S.next(0, cur)) return;
    f32x4 acc[2][2][4][2];
#pragma unroll
    for (int a = 0; a < 2; ++a)
#pragma unroll
        for (int b = 0; b < 2; ++b)
#pragma unroll
            for (int m = 0; m < 4; ++m)
#pragma unroll
                for (int n = 0; n < 2; ++n) { double z0_, z1_; asm volatile("v_mov_b64 %0, 0\n\tv_mov_b64 %1, 0" : "=v"(z0_), "=v"(z1_));
                    const v2d_ zz_ = {z0_, z1_}; acc[a][b][m][n] = __builtin_bit_cast(f32x4, zz_); }
    bf16x8 At[4][2], B0[2][2], B1[2][2];
    const char* cA = (const char*)g.A + (size_t)cur.pm * tstep + (size_t)cur.k0 * kstep; const char* cB = (const char*)g.Bt + (size_t)cur.pn * tstep + (size_t)cur.k0 * kstep;
    S.a_ready(cur);
    if constexpr (SP2) {
        PG8_STAGE(PG8_SB(0, 0), cB, voffB); PG8_STAGE(PG8_SB(0, 1), cB + hstep, voffB); PG8_STAGE(PG8_SA(0, 0), cA, voffA); PG8_STAGE(PG8_SA(0, 1), cA + hstep, voffA);
        if (wr == 1) PG8_BAR;
        PG8_WAIT_V(2); PG8_BAR;
        PG8_STAGE(PG8_SB(1, 0), cB + kstep, voffB); PG8_STAGE(PG8_SA(1, 0), cA + kstep, voffA); PG8_STAGE(PG8_SB(1, 1), cB + hstep + kstep, voffB);
        PG8_WAIT_V(6); PG8_BAR;
    } else {
        PG8_STAGE(PG8_SB(0, 0), cB, voffB); PG8_STAGE(PG8_SA(0, 0), cA, voffA); PG8_STAGE(PG8_SB(0, 1), cB + hstep, voffB); PG8_STAGE(PG8_SA(0, 1), cA + hstep, voffA);
        if (wr == 1) PG8_BAR;
        PG8_WAIT_V(4); PG8_BAR;
        PG8_STAGE(PG8_SB(1, 0), cB + kstep, voffB); PG8_STAGE(PG8_SA(1, 0), cA + kstep, voffA); PG8_STAGE(PG8_SB(1, 1), cB + hstep + kstep, voffB);
        PG8_WAIT_V(6); PG8_BAR;
    }
    for (;;) {
        const bool has_next = S.next(ui + 1, nxt);
        const char* nA = has_next ? (const char*)g.A + (size_t)nxt.pm * tstep + (size_t)nxt.k0 * kstep : cA; const char* nB = has_next ? (const char*)g.Bt + (size_t)nxt.pn * tstep + (size_t)nxt.k0 * kstep : cB;
        const int nt = cur.nk;
        for (int t = 0; t < nt; t += 2) {
            const bool last = (t == nt - 2);
            const char* a1 = cA + (size_t)(t + 1) * kstep;
            const char* a2 = last ? nA : cA + (size_t)(t + 2) * kstep; const char* b2 = last ? nB : cB + (size_t)(t + 2) * kstep;
            const char* a3 = a2 + kstep; const char* b3 = b2 + kstep;
            if (last && has_next) S.a_ready(nxt);
            if constexpr (SP2) {
            PG8_LDB(B0, 0, 0); PG8_LDB(B1, 0, 1); PG8_SCHED; PG8_LDA(At, 0, 0); PG8_STAGE(PG8_SA(1, 1), a1 + hstep, voffA);
            PG8_WAIT_V(8); PG8_WAIT_L(0); PG8_BAR; PG8_MMA(0, 0, At, B0); PG8_MMA(0, 1, At, B1); PG8_BAR; PG8_SCHED;
            PG8_LDA(At, 0, 1); PG8_STAGE(PG8_SB(0, 0), b2, voffB); PG8_STAGE(PG8_SB(0, 1), b2 + hstep, voffB); PG8_STAGE(PG8_SA(0, 0), a2, voffA);
            PG8_WAIT_V(8); PG8_WAIT_L(0); PG8_BAR; PG8_MMA(1, 0, At, B0); PG8_MMA(1, 1, At, B1); PG8_BAR; PG8_SCHED;
            PG8_LDB(B0, 1, 0); PG8_LDB(B1, 1, 1); PG8_SCHED; PG8_LDA(At, 1, 0); PG8_STAGE(PG8_SA(0, 1), a2 + hstep, voffA);
            PG8_WAIT_V(8); PG8_WAIT_L(0); PG8_BAR; PG8_MMA(0, 0, At, B0); PG8_MMA(0, 1, At, B1); PG8_BAR; PG8_SCHED;
            PG8_LDA(At, 1, 1); PG8_STAGE(PG8_SB(1, 0), b3, voffB); PG8_STAGE(PG8_SB(1, 1), b3 + hstep, voffB); PG8_STAGE(PG8_SA(1, 0), a3, voffA);
            PG8_WAIT_V(8); PG8_WAIT_L(0); PG8_BAR; PG8_MMA(1, 0, At, B0); PG8_MMA(1, 1, At, B1); PG8_BAR; PG8_SCHED;
            } else {
            PG8_LDB(B0, 0, 0); PG8_SCHED; PG8_LDA(At, 0, 0); PG8_STAGE(PG8_SA(1, 1), a1 + hstep, voffA);
            PG8_WAIT_L(8); PG8_BAR; PG8_WAIT_L(0); PG8_MMA(0, 0, At, B0); PG8_BAR; PG8_SCHED;
            PG8_LDB(B1, 0, 1); PG8_STAGE(PG8_SB(0, 0), b2, voffB);
            PG8_BAR; PG8_WAIT_L(0); PG8_MMA(0, 1, At, B1); PG8_BAR;
            PG8_LDA(At, 0, 1); PG8_STAGE(PG8_SA(0, 0), a2, voffA);
            PG8_BAR; PG8_WAIT_L(0); PG8_MMA(1, 0, At, B0); PG8_BAR; PG8_SCHED;
            PG8_STAGE(PG8_SB(0, 1), b2 + hstep, voffB);
            PG8_WAIT_V(6); PG8_BAR; PG8_MMA(1, 1, At, B1); PG8_BAR;
            PG8_LDB(B0, 1, 0); PG8_SCHED; PG8_LDA(At, 1, 0); PG8_STAGE(PG8_SA(0, 1), a2 + hstep, voffA);
            PG8_WAIT_L(8); PG8_BAR; PG8_WAIT_L(0); PG8_MMA(0, 0, At, B0); PG8_BAR; PG8_SCHED;
            PG8_LDB(B1, 1, 1); PG8_STAGE(PG8_SB(1, 0), b3, voffB);
            PG8_BAR; PG8_WAIT_L(0); PG8_MMA(0, 1, At, B1); PG8_BAR;
            PG8_LDA(At, 1, 1); PG8_STAGE(PG8_SA(1, 0), a3, voffA);
            PG8_BAR; PG8_WAIT_L(0); PG8_MMA(1, 0, At, B0); PG8_BAR; PG8_SCHED;
            PG8_STAGE(PG8_SB(1, 1), b3 + hstep, voffB);
            PG8_WAIT_V(6); PG8_BAR; PG8_MMA(1, 1, At, B1); PG8_BAR;
            }
        }
        if constexpr (ALIGN_EPI) { if (wr == 0) PG8_BAR; }
        if constexpr (FP8) asm volatile("s_nop 7\n\ts_nop 7\n\ts_nop 7" ::: "memory");
        if constexpr (!Epi::AFTER_DRAIN) { E(acc, cur, wr, wc, fr, fq); S.done(cur); }
        if (!has_next) break;
#pragma unroll
        for (int a = 0; a < 2; ++a)
#pragma unroll
            for (int b = 0; b < 2; ++b)
#pragma unroll
                for (int m = 0; m < 4; ++m)
#pragma unroll
                    for (int n = 0; n < 2; ++n) { double z0_, z1_; asm volatile("v_mov_b64 %0, 0\n\tv_mov_b64 %1, 0" : "=v"(z0_), "=v"(z1_));
                    const v2d_ zz_ = {z0_, z1_}; acc[a][b][m][n] = __builtin_bit_cast(f32x4, zz_); }
        cur = nxt; cA = nA; cB = nB; ++ui;
        if constexpr (ALIGN_EPI) { if (wr == 1) PG8_BAR; }
    }
    PG8_WAIT_V(0);
    if constexpr (!ALIGN_EPI) { if (wr == 0) PG8_BAR; }
    PG8_BAR;
    if constexpr (Epi::AFTER_DRAIN) { E.fused(acc, cur, wr, wc, fr, fq, lds, wid, lane); S.done(cur); }
#undef PG8_SA
#undef PG8_SB
#undef PG8_STAGE
#undef PG8_LDA
#undef PG8_LDB
#undef PG8_MMA
#undef PG8_WAIT_V
#undef PG8_WAIT_L
#undef PG8_BAR
#undef PG8_SCHED
}
}

typedef unsigned short bf16;
typedef unsigned v4u __attribute__((ext_vector_type(4)));
typedef unsigned v2u __attribute__((ext_vector_type(2)));
typedef float f32x4 __attribute__((ext_vector_type(4)));
typedef short bf16x8 __attribute__((ext_vector_type(8)));
typedef short s16x4 __attribute__((ext_vector_type(4)));
typedef short v4i16_t __attribute__((ext_vector_type(4)));
typedef GAS unsigned gu32;
#define RLX_AGENT __ATOMIC_RELAXED, __HIP_MEMORY_SCOPE_AGENT
using pg8::pk2;
__device__ __forceinline__ float bf2f(unsigned short h) { return __builtin_bit_cast(float, (unsigned)h << 16); }
__device__ __forceinline__ float bflo(unsigned w) { return __builtin_bit_cast(float, w << 16); }
__device__ __forceinline__ float bfhi(unsigned w) { return __builtin_bit_cast(float, w & 0xffff0000u); }
__device__ __forceinline__ f32x4 mfma16(bf16x8 a, bf16x8 b, f32x4 c) { return __builtin_amdgcn_mfma_f32_16x16x32_bf16(a, b, c, 0, 0, 0); }
__device__ __forceinline__ s16x4 ds_tr(const LAS unsigned char* p) { return __builtin_bit_cast(s16x4, __builtin_amdgcn_ds_read_tr16_b64_v4i16((LAS v4i16_t*)p)); }
__device__ __forceinline__ bf16x8 cat4(s16x4 a, s16x4 b) { bf16x8 r; r[0] = a[0]; r[1] = a[1]; r[2] = a[2]; r[3] = a[3]; r[4] = b[0]; r[5] = b[1]; r[6] = b[2]; r[7] = b[3]; return r; }
__device__ __forceinline__ bf16x8 pack8f(f32x4 a, f32x4 b) { v4u w; w.x = pk2(a[0], a[1]); w.y = pk2(a[2], a[3]); w.z = pk2(b[0], b[1]); w.w = pk2(b[2], b[3]); return __builtin_bit_cast(bf16x8, w); }
__device__ __forceinline__ float wave_sum(float v) {
#pragma unroll
    for (int o = 1; o < 64; o <<= 1) v += __shfl_xor(v, o);
    return v;
}
__device__ __forceinline__ float wave_max(float v) {
#pragma unroll
    for (int o = 1; o < 64; o <<= 1) v = fmaxf(v, __shfl_xor(v, o));
    return v;
}


__device__ __forceinline__ void st16_pair(bf16* rowp, int t0, int t1, v2u wa, v2u wb, int g) {
    const auto s0 = __builtin_amdgcn_permlane16_swap(wa.x, wb.x, false, false); const auto s1 = __builtin_amdgcn_permlane16_swap(wa.y, wb.y, false, false);
    v4u o; o.x = s0[0]; o.y = s1[0]; o.z = s0[1]; o.w = s1[1];
    *(GAS v4u*)(rowp + 16 * ((g & 1) ? t1 : t0) + 8 * (g >> 1)) = o;
}
__device__ __forceinline__ v4u ld16_raw(const bf16* rowp, int t0, int t1, int g) { return *(const GAS v4u*)(rowp + 16 * ((g & 1) ? t1 : t0) + 8 * (g >> 1)); }
__device__ __forceinline__ void ul16_pair(v4u i, v2u& wa, v2u& wb) {
    const auto s0 = __builtin_amdgcn_permlane16_swap(i.x, i.z, false, false); const auto s1 = __builtin_amdgcn_permlane16_swap(i.y, i.w, false, false);
    wa.x = s0[0]; wb.x = s0[1]; wa.y = s1[0]; wb.y = s1[1];
}
__device__ __forceinline__ void ld16_pair(const bf16* rowp, int t0, int t1, v2u& wa, v2u& wb, int g) {
    const v4u i = *(const GAS v4u*)(rowp + 16 * ((g & 1) ? t1 : t0) + 8 * (g >> 1));
    const auto s0 = __builtin_amdgcn_permlane16_swap(i.x, i.z, false, false); const auto s1 = __builtin_amdgcn_permlane16_swap(i.y, i.w, false, false);
    wa.x = s0[0]; wb.x = s0[1]; wa.y = s1[0]; wb.y = s1[1];
}

#define XB_TMO      128
#define XB_XCNT(j)  (256  + 64 * (j))
#define XB_XSUB(j)  (1280 + 64 * (j))
#define XB_XGEN(j)  (2304 + 64 * (j))
#define XB_TOP      3328
#define XB_TOPGEN   3392
#define XCD_BAR_WORDS 3456
#define XB_SPIN_CAP (1u << 18)

__device__ __forceinline__ unsigned xb_ld(unsigned* p)              { return __hip_atomic_load(p, __ATOMIC_RELAXED, __HIP_MEMORY_SCOPE_AGENT); }
__device__ __forceinline__ unsigned xb_add(unsigned* p, unsigned v) { return __hip_atomic_fetch_add(p, v, __ATOMIC_RELAXED, __HIP_MEMORY_SCOPE_AGENT); }
__device__ __forceinline__ unsigned xb_xcc_id() { return (unsigned)__builtin_amdgcn_s_getreg((3 << 11) | 20) & 0xFu; }
#define XB_SPIN(cond, bar) do { unsigned _sp = 0; while (cond) { __builtin_amdgcn_s_sleep(1); \
    if ((++_sp & 255u) == 0u) { if (xb_ld(&(bar)[XB_TMO])) break; if (_sp > XB_SPIN_CAP) { atomicAdd(&(bar)[XB_TMO], 1u); break; } } } } while (0)

struct XcdBarrier {
    unsigned* bar; unsigned x;
    volatile LAS unsigned* st;
};
__device__ __forceinline__ XcdBarrier xcd_barrier_post(unsigned* bar, volatile LAS unsigned* st) {
    XcdBarrier b; b.bar = bar; b.x = xb_xcc_id(); b.st = st;
    if (threadIdx.x == 0) (void)xb_add(&bar[XB_XCNT(b.x)], 1u);
    return b;
}
__device__ __forceinline__ void xcd_barrier_complete(unsigned* bar, unsigned x, unsigned& nloc, unsigned& nx) {
    const unsigned G = gridDim.x * gridDim.y * gridDim.z;
    unsigned sum, cnt, mine, sp = 0u;
    for (;;) {
        sum = 0u; cnt = 0u; mine = 0u;
#pragma unroll
        for (unsigned j = 0; j < 16; ++j) { const unsigned c = xb_ld(&bar[XB_XCNT(j)]); sum += c; cnt += (c > 0u) ? 1u : 0u; mine = (j == x) ? c : mine; }
        if (sum == G) break;
        __builtin_amdgcn_s_sleep(1);
        if ((++sp & 255u) == 0u) { if (xb_ld(&bar[XB_TMO])) break; if (sp > XB_SPIN_CAP) { atomicAdd(&bar[XB_TMO], 1u); break; } }
    }
    nloc = mine > 0u ? mine : 1u; nx = cnt > 0u ? cnt : 1u;
}
__device__ __forceinline__ void xcd_barrier(const XcdBarrier& b) {
    __builtin_amdgcn_s_waitcnt(0x0F70);
    asm volatile("" ::: "memory");
    __syncthreads();
    if (threadIdx.x == 0) {
        unsigned* bar = b.bar;
        __builtin_amdgcn_s_waitcnt(0);
        unsigned nloc = b.st[0], nx = b.st[1];
        if (nloc == 0u) { xcd_barrier_complete(bar, b.x, nloc, nx); b.st[0] = nloc; b.st[1] = nx; }
        const unsigned old = xb_add(&bar[XB_XSUB(b.x)], 1u);
        const unsigned gen = old / nloc;
        if (old + 1u == (gen + 1u) * nloc) {
            __builtin_amdgcn_fence(__ATOMIC_RELEASE, "agent");
            asm volatile("s_waitcnt vmcnt(0)" ::: "memory");
            const unsigned og = xb_add(&bar[XB_TOP], 1u);
            const unsigned tg = og / nx;
            if (og + 1u == (tg + 1u) * nx) xb_add(&bar[XB_TOPGEN], 1u);
            else XB_SPIN(xb_ld(&bar[XB_TOPGEN]) == tg, bar);
            __builtin_amdgcn_fence(__ATOMIC_ACQUIRE, "agent");
            xb_add(&bar[XB_XGEN(b.x)], 1u);
            asm volatile("s_waitcnt vmcnt(0)" ::: "memory");
        } else {
            XB_SPIN(xb_ld(&bar[XB_XGEN(b.x)]) == gen, bar);
            __builtin_amdgcn_fence(__ATOMIC_ACQUIRE, "agent");
            asm volatile("s_waitcnt vmcnt(0)" ::: "memory");
        }
    }
    __syncthreads();
}

struct Frame {
    LAS unsigned char* lds;
    volatile LAS unsigned* MISC;
    gu32* ctl;
    int tid, lane, wave, G;
    const float* in[23];
    float* out;
    unsigned char* ws;
};
#define WSP(T, off) ((T*)(F.ws + (off)))

template <bool FP8 = false>
__device__ __forceinline__ void p0_item(const float* W, int ldw, int scol0, int nvalid, const float* gain, bf16* Bt, int K, int drow0, int k0, LAS float* scr, int lane, float f8s = 64.f) {
    float wv_[32];
#pragma unroll
    for (int i = 0; i < 32; ++i) { const int kk = 2 * i + (lane >> 5), j = lane & 31; wv_[i] = (j < nvalid) ? W[(size_t)(k0 + kk) * ldw + scol0 + j] : 0.f; }
    const float gl_ = gain ? gain[k0 + lane] : 1.f;
#pragma unroll
    for (int i = 0; i < 32; ++i) { const int kk = 2 * i + (lane >> 5), j = lane & 31; scr[kk * 33 + j] = wv_[i] * __shfl(gl_, kk); }
    asm volatile("s_waitcnt lgkmcnt(0)" ::: "memory");
    const int c = lane & 7;
#pragma unroll
    for (int jj = 0; jj < 4; ++jj) { const int n = (lane >> 3) + 8 * jj; const LAS float* s = scr + (8 * c) * 33 + n;
        if (FP8) {
            int w0 = 0, w1 = 0;
            w0 = __builtin_amdgcn_cvt_pk_fp8_f32(s[0 * 33] * f8s, s[1 * 33] * f8s, w0, false); w0 = __builtin_amdgcn_cvt_pk_fp8_f32(s[2 * 33] * f8s, s[3 * 33] * f8s, w0, true);
            w1 = __builtin_amdgcn_cvt_pk_fp8_f32(s[4 * 33] * f8s, s[5 * 33] * f8s, w1, false); w1 = __builtin_amdgcn_cvt_pk_fp8_f32(s[6 * 33] * f8s, s[7 * 33] * f8s, w1, true);
            *(GAS v2u*)((unsigned char*)Bt + (size_t)(drow0 + n) * K + k0 + 8 * c) = (v2u){(unsigned)w0, (unsigned)w1};
        } else {
        v4u o; o.x = pk2(s[0 * 33], s[1 * 33]); o.y = pk2(s[2 * 33], s[3 * 33]); o.z = pk2(s[4 * 33], s[5 * 33]); o.w = pk2(s[6 * 33], s[7 * 33]);
        *(GAS v4u*)(Bt + (size_t)(drow0 + n) * K + k0 + 8 * c) = o; } }
    asm volatile("s_waitcnt lgkmcnt(0)" ::: "memory");
}
__device__ __forceinline__ void p0_rows(Frame& F, int lo, int hi, int gw, int NGW) {
    const int lane = F.lane;
    bf16* XB = WSP(bf16, WS_XB); float* RS = WSP(float, WS_RS);
    const float *xp = F.in[0], *xs = F.in[1]; asm volatile("" : "+s"(xp), "+s"(xs));
    constexpr int RPT = 4;
    f32x4 nv[RPT][4];
    auto ldrows = [&](int m0) {
#pragma unroll
        for (int q = 0; q < RPT; ++q) { const int m = m0 + q; const float* xrow = m < MP ? xp + (size_t)m * D : xs + (size_t)(m - MP) * D; const GAS f32x4* xr = (const GAS f32x4*)xrow + lane;
#pragma unroll
            for (int j = 0; j < 4; ++j) nv[q][j] = xr[64 * j]; } };
    if (lo + RPT * gw < hi) ldrows(lo + RPT * gw);
    for (int m0 = lo + RPT * gw; m0 < hi; m0 += RPT * NGW) {
        f32x4 v[RPT][4];
#pragma unroll
        for (int q = 0; q < RPT; ++q)
#pragma unroll
            for (int j = 0; j < 4; ++j) v[q][j] = nv[q][j];
        if (m0 + RPT * NGW < hi) ldrows(m0 + RPT * NGW);
        asm volatile("" ::: "memory");
#pragma unroll
        for (int q = 0; q < RPT; ++q) { const int m = m0 + q; float sq = 0.f;
#pragma unroll
            for (int j = 0; j < 4; ++j) sq += (v[q][j][0] * v[q][j][0] + v[q][j][1] * v[q][j][1]) + (v[q][j][2] * v[q][j][2] + v[q][j][3] * v[q][j][3]);
            const float s = wave_sum(sq);
            GAS v2u* o8 = (GAS v2u*)(XB + (size_t)m * D) + lane;
#pragma unroll
            for (int j = 0; j < 4; ++j) { v2u w; w.x = pk2(v[q][j][0], v[q][j][1]); w.y = pk2(v[q][j][2], v[q][j][3]); o8[64 * j] = w; }
            if (lane == 0) RS[m] = __builtin_amdgcn_rsqf(s * (1.f / 1024.f) + EPS); }
    }
}
template <int PART> __device__ __forceinline__ void p0_part(Frame& F, int gw, int NGW) {
    LAS float* scr = (LAS float*)(F.lds + F.wave * 16384);
    const int lane = F.lane;
    constexpr int I_GU = 176 * 16, I_D = 32 * 44, I_IN = 120 * 16, I_O = 32 * 16;
    if constexpr (PART == 0) {
        const float *wg1 = F.in[8], *wu1 = F.in[9], *gn1 = F.in[7];
        asm volatile("" : "+s"(wg1), "+s"(wu1), "+s"(gn1));
        for (int it = gw; it < I_GU; it += NGW) { const int gi = (it & 7) + 8 * (it >> 7), kb = (it >> 3) & 15; const int pn = gi >> 3, q = gi & 7, bj = q >> 2, wcg = q & 3;
            const float* W = bj ? wu1 : wg1;
            p0_item<false>(W, FF, 128 * pn + 32 * wcg, 32, gn1, WSP(bf16, WS_WGU1), D, 32 * gi, 64 * kb, scr, lane); }
    } else {
        const float *wg2 = F.in[20], *wu2 = F.in[21], *gn2 = F.in[19], *wd1 = F.in[10], *wd2 = F.in[22];
        asm volatile("" : "+s"(wg2), "+s"(wu2), "+s"(gn2), "+s"(wd1), "+s"(wd2));
        for (int it = gw; it < I_GU + 2 * I_D + I_IN + I_O; it += NGW) {
            int r = it;
            if (r < I_D) { const int gi = (r & 7) + 8 * ((r >> 3) / 44), kb = (r >> 3) % 44; p0_item<false>(wd1, D, 32 * gi, 32, nullptr, WSP(bf16, WS_WD1), FF, 32 * gi, 64 * kb, scr, lane); continue; }
            r -= I_D;
            if (r < I_GU) { const int gi = (r & 7) + 8 * (r >> 7), kb = (r >> 3) & 15; const int pn = gi >> 3, q = gi & 7, bj = q >> 2, wcg = q & 3;
                const float* W = bj ? wu2 : wg2;
                p0_item<true>(W, FF, 128 * pn + 32 * wcg, 32, gn2, WSP(bf16, WS_WGU2), D, 32 * gi, 64 * kb, scr, lane, 32.f); continue; }
            r -= I_GU;
            if (r < I_D) { const int gi = (r & 7) + 8 * ((r >> 3) / 44), kb = (r >> 3) % 44; p0_item<true>(wd2, D, 32 * gi, 32, nullptr, WSP(bf16, WS_WD2), FF, 32 * gi, 64 * kb, scr, lane); continue; }
            r -= I_D;
            if (r < I_IN) { const int gi = (r & 7) + 8 * (r >> 7), kb = (r >> 3) & 15; const int pn = gi >> 3, q = gi & 7, bj = q >> 2, wcg = q & 3;
                int scol, nv = 32;
                if (pn < 4) scol = 256 * pn + 64 * wcg + 32 * bj; else if (pn < 14) scol = 256 * pn + 32 * q; else { scol = 3584; nv = (q == 0) ? 8 : 0; }
                p0_item(F.in[12], INW, scol, nv, F.in[11], WSP(bf16, WS_WIN), D, 32 * gi, 64 * kb, scr, lane); continue; }
            r -= I_IN;
            { const int gi = (r & 7) + 8 * (r >> 7), kb = (r >> 3) & 15; p0_item(F.in[18], D, 32 * gi, 32, nullptr, WSP(bf16, WS_WOUT), D, 32 * gi, 64 * kb, scr, lane); }
        }
    }
    if constexpr (PART == 0) p0_rows(F, MP, MT, gw, NGW);
    if constexpr (PART == 1) {
    float* rope = WSP(float, WS_ROPE);
    for (int e = (gw >> 3) * 512 + F.tid; e < NROPE * 32; e += (NGW >> 3) * 512) {
        const int prow = e >> 5, f = e & 31; const double pos = prow < SEQ ? (double)prow : (double)(PAST + prow - SEQ);
        double inv = 1.0; for (int i = 0; i < f; ++i) inv *= 0.74989420933245582730;
        const double x = pos * inv * 0.15915494309189533577;
        const double fr = x - __builtin_rint(x); const double a = fr * 6.28318530717958647693, a2 = a * a;
        double sn = 0.0, cs = 0.0;
#pragma unroll
        for (int k = 14; k >= 1; --k) { sn = 1.0 - sn * a2 / (double)((2 * k) * (2 * k + 1)); cs = 1.0 - cs * a2 / (double)((2 * k - 1) * (2 * k)); }
        sn *= a;
        rope[(size_t)prow * 64 + f] = (float)cs; rope[(size_t)prow * 64 + 32 + f] = (float)sn;
    }
    }
}

constexpr int AKS = 144;
constexpr int ABLK = 2 * 128 * AKS;
struct AttPF { v4u k[2], v[2]; bf16x8 q[2]; };
__device__ __forceinline__ void att_rc(int pat, int s, int& r, int& c) { r = pat == 0 ? 0 : pat == 1 ? (s >> 2) : s; c = pat == 0 ? s : pat == 1 ? (s & 3) : 0; }
__device__ __forceinline__ void att_load(Frame& F, int b, int h, int pat, int d, int s, AttPF& P) {
    const bf16* Qb = WSP(bf16, WS_Q); const bf16* Kb = WSP(bf16, WS_K); const bf16* Vb = WSP(bf16, WS_V);
    int r, c; att_rc(pat, s, r, c); const size_t rb = (size_t)b * SEQ + r; const int srow = F.tid >> 3, sch = F.tid & 7;
#pragma unroll
    for (int p = 0; p < 2; ++p) { const size_t ge = att_idx(rb + (size_t)d * (128 * c + srow + 64 * p), h) + sch * 8; P.k[p] = *(const GAS v4u*)(Kb + ge); P.v[p] = *(const GAS v4u*)(Vb + ge); }
    const size_t qr = rb + (size_t)d * (128 * c + 16 * F.wave + (F.lane & 15));
#pragma unroll
    for (int kk = 0; kk < 2; ++kk) P.q[kk] = *(const GAS bf16x8*)(Qb + att_idx(qr, h) + 32 * kk + 8 * (F.lane >> 4));
}
__device__ __forceinline__ void st_bf8_as_f32(float* dst, v4u w) {
    *(GAS f32x4*)dst = (f32x4){bflo(w.x), bfhi(w.x), bflo(w.y), bfhi(w.y)}; *(GAS f32x4*)(dst + 4) = (f32x4){bflo(w.z), bfhi(w.z), bflo(w.w), bfhi(w.w)};
}
__device__ __forceinline__ void att_store(Frame& F, int b, int h, int pat, int s, const AttPF& P) {
    LAS unsigned char* sl = F.lds + (s % 3) * ABLK; const int srow = F.tid >> 3, sch = F.tid & 7;
#pragma unroll
    for (int p = 0; p < 2; ++p) { *(LAS v4u*)(sl + (srow + 64 * p) * AKS + sch * 16) = P.k[p]; *(LAS v4u*)(sl + 128 * AKS + (srow + 64 * p) * AKS + sch * 16) = P.v[p]; }
}
template <bool FULL>
__device__ __forceinline__ void att_compute(const LAS unsigned char* blkP, const LAS unsigned char* blkC, const bf16x8 (&qf)[2], int w, int ql, int g, int tq, int tp, f32x4 (&o)[4], float& mx_out, float& l_out) {
    const LAS unsigned char* toff[9];
#pragma unroll
    for (int jt = 0; jt < 9; ++jt) { const int rel = 16 * w + 16 * jt; toff[jt] = FULL ? (rel < 128 ? blkP + rel * AKS : blkC + (rel - 128) * AKS) : blkC + (rel - 128) * AKS; }
    f32x4 sc[9];
    if (FULL) {
        {   bf16x8 kf[5][2];
#pragma unroll
            for (int jt = 0; jt < 5; ++jt)
#pragma unroll
                for (int kk = 0; kk < 2; ++kk) kf[jt][kk] = *(const LAS bf16x8*)(toff[jt] + ql * AKS + 16 * g + 64 * kk);
#pragma unroll
            for (int jt = 0; jt < 5; ++jt) { f32x4 a = {0.f, 0.f, 0.f, 0.f}; a = mfma16(kf[jt][0], qf[0], a); a = mfma16(kf[jt][1], qf[1], a); sc[jt] = a; } }
        {   bf16x8 kf[4][2];
#pragma unroll
            for (int jt = 0; jt < 4; ++jt)
#pragma unroll
                for (int kk = 0; kk < 2; ++kk) kf[jt][kk] = *(const LAS bf16x8*)(toff[5 + jt] + ql * AKS + 16 * g + 64 * kk);
#pragma unroll
            for (int jt = 0; jt < 4; ++jt) { f32x4 a = {0.f, 0.f, 0.f, 0.f}; a = mfma16(kf[jt][0], qf[0], a); a = mfma16(kf[jt][1], qf[1], a); sc[5 + jt] = a; } }
    } else {
#pragma unroll
        for (int jt = 0; jt < 9; ++jt) { sc[jt] = (f32x4){-1e30f, -1e30f, -1e30f, -1e30f};
            if (w + jt >= 8) { f32x4 a = {0.f, 0.f, 0.f, 0.f};
#pragma unroll
                for (int kk = 0; kk < 2; ++kk) a = mfma16(*(const LAS bf16x8*)(toff[jt] + ql * AKS + 16 * g + 64 * kk), qf[kk], a);
                sc[jt] = a; } }
    }
    float mx = -1e30f;
    if (FULL) {
        s16x4 vf[3][4][2];
#pragma unroll
        for (int jp = 0; jp < 3; ++jp) { const LAS unsigned char* a0 = toff[2 * jp] + 128 * AKS + (4 * g + tq) * AKS + 8 * tp; const LAS unsigned char* a1 = toff[2 * jp + 1] + 128 * AKS + (4 * g + tq) * AKS + 8 * tp;
#pragma unroll
            for (int dv = 0; dv < 4; ++dv) { vf[jp][dv][0] = ds_tr(a0 + 32 * dv); vf[jp][dv][1] = ds_tr(a1 + 32 * dv); } }
#pragma unroll
        for (int e4 = 0; e4 < 4; ++e4) { const int e = 4 * g + e4; sc[0][e4] = (e >= ql) ? sc[0][e4] : -1e30f; sc[8][e4] = (e <= ql) ? sc[8][e4] : -1e30f; }
#pragma unroll
        for (int jt = 0; jt < 9; ++jt) mx = fmaxf(mx, fmaxf(fmaxf(sc[jt][0], sc[jt][1]), fmaxf(sc[jt][2], sc[jt][3])));
        mx = fmaxf(mx, __shfl_xor(mx, 16)); mx = fmaxf(mx, __shfl_xor(mx, 32));
        float l = 0.f;
#pragma unroll
        for (int jt = 0; jt < 9; ++jt)
#pragma unroll
            for (int e4 = 0; e4 < 4; ++e4) { const float p = __builtin_amdgcn_exp2f(sc[jt][e4] - mx); sc[jt][e4] = p; l += p; }
        l += __shfl_xor(l, 16); l += __shfl_xor(l, 32);
#pragma unroll
        for (int dv = 0; dv < 4; ++dv) o[dv] = (f32x4){0.f, 0.f, 0.f, 0.f};
        s16x4 vg[2][4][2];
#pragma unroll
        for (int jp = 3; jp < 5; ++jp) { const LAS unsigned char* a0 = toff[2 * jp] + 128 * AKS + (4 * g + tq) * AKS + 8 * tp; const LAS unsigned char* a1 = toff[jp < 4 ? 2 * jp + 1 : 8] + 128 * AKS + (4 * g + tq) * AKS + 8 * tp;
#pragma unroll
            for (int dv = 0; dv < 4; ++dv) { vg[jp - 3][dv][0] = ds_tr(a0 + 32 * dv); vg[jp - 3][dv][1] = ds_tr(a1 + 32 * dv); } }
#pragma unroll
        for (int jp = 0; jp < 3; ++jp) { const bf16x8 pf = pack8f(sc[2 * jp], sc[2 * jp + 1]);
#pragma unroll
            for (int dv = 0; dv < 4; ++dv) o[dv] = mfma16(cat4(vf[jp][dv][0], vf[jp][dv][1]), pf, o[dv]); }
#pragma unroll
        for (int jp = 3; jp < 5; ++jp) { const bf16x8 pf = (jp < 4) ? pack8f(sc[2 * jp], sc[2 * jp + 1]) : pack8f(sc[8], (f32x4){0.f, 0.f, 0.f, 0.f});
#pragma unroll
            for (int dv = 0; dv < 4; ++dv) o[dv] = mfma16(cat4(vg[jp - 3][dv][0], vg[jp - 3][dv][1]), pf, o[dv]); }
        mx_out = mx; l_out = l;
    } else {
#pragma unroll
        for (int e4 = 0; e4 < 4; ++e4) { const int e = 4 * g + e4; sc[8][e4] = (e <= ql) ? sc[8][e4] : -1e30f; }
#pragma unroll
        for (int jt = 1; jt < 9; ++jt) if (w + jt >= 8) mx = fmaxf(mx, fmaxf(fmaxf(sc[jt][0], sc[jt][1]), fmaxf(sc[jt][2], sc[jt][3])));
        mx = fmaxf(mx, __shfl_xor(mx, 16)); mx = fmaxf(mx, __shfl_xor(mx, 32));
        float l = 0.f;
#pragma unroll
        for (int jt = 1; jt < 9; ++jt) { if (w + jt >= 8) {
#pragma unroll
                for (int e4 = 0; e4 < 4; ++e4) { const float p = __builtin_amdgcn_exp2f(sc[jt][e4] - mx); sc[jt][e4] = p; l += p; } }
            else sc[jt] = (f32x4){0.f, 0.f, 0.f, 0.f}; }
        l += __shfl_xor(l, 16); l += __shfl_xor(l, 32);
#pragma unroll
        for (int dv = 0; dv < 4; ++dv) o[dv] = (f32x4){0.f, 0.f, 0.f, 0.f};
        const LAS unsigned char* vdiag = toff[8] + 128 * AKS + (4 * g + tq) * AKS + 8 * tp;
#pragma unroll
        for (int jp = 1; jp < 5; ++jp) { const int j0 = 2 * jp - 1, j1 = 2 * jp;
            if (w + j1 >= 8) { const bf16x8 pf = pack8f(sc[j0], sc[j1]);
                const LAS unsigned char* a0 = (w + j0 >= 8) ? toff[j0] + 128 * AKS + (4 * g + tq) * AKS + 8 * tp : vdiag; const LAS unsigned char* a1 = toff[j1] + 128 * AKS + (4 * g + tq) * AKS + 8 * tp;
#pragma unroll
                for (int dv = 0; dv < 4; ++dv) o[dv] = mfma16(cat4(ds_tr(a0 + 32 * dv), ds_tr(a1 + 32 * dv)), pf, o[dv]); } }
        mx_out = mx; l_out = l;
    }
}
template <bool MERGE, int VAR = 0>
__device__ __forceinline__ void attn_step(Frame& F, int b, int h, int pat, int d, int s, AttPF& LD, const AttPF& ST, bf16x8 (&qf)[2]) {
    const int lane = F.lane, w = F.wave;
    const int ql = lane & 15, g = lane >> 4, tq = (lane & 15) >> 2, tp = lane & 3;
    int r, c; att_rc(pat, s, r, c);
    const size_t qrow = (size_t)b * SEQ + r + (size_t)d * (128 * c + 16 * w + ql);
    v2u mo0[4], mo1[4]; float l0 = 0.f, l1 = 0.f; v4u rawp0 = {0u, 0u, 0u, 0u}, rawp1 = rawp0, rawp2 = rawp0, rawp3 = rawp0;
    if (MERGE) { const bf16* OP0 = WSP(bf16, WS_OP); const bf16* OP1 = OP0 + (size_t)MP * 512; const float* L0 = WSP(float, WS_LSE); const float* L1 = L0 + (size_t)MP * 8;
        l0 = L0[att_idx(qrow, h) >> 6]; l1 = L1[att_idx(qrow, h) >> 6];
        v4u raw[4];
        raw[0] = ld16_raw(OP0 + att_idx(qrow, h), 0, 1, g); raw[1] = ld16_raw(OP0 + att_idx(qrow, h), 2, 3, g);
        raw[2] = ld16_raw(OP1 + att_idx(qrow, h), 0, 1, g); raw[3] = ld16_raw(OP1 + att_idx(qrow, h), 2, 3, g);
        rawp0 = raw[0]; rawp1 = raw[1]; rawp2 = raw[2]; rawp3 = raw[3];
        asm volatile("" ::: "memory"); }
    if (VAR != 2 && VAR != 4) { if (s + 2 < 16) att_load(F, b, h, pat, d, s + 2, LD); }
    const LAS unsigned char* blkP = F.lds + ((s + 2) % 3) * ABLK; const LAS unsigned char* blkC = F.lds + (s % 3) * ABLK;
    f32x4 o[4]; float mx, l;
    if (VAR == 5) { mx = 0.f; l = 1.f; o[0] = o[1] = o[2] = o[3] = (f32x4){0.f, 0.f, 0.f, 0.f}; }
    else if (c > 0) att_compute<true>(blkP, blkC, qf, w, ql, g, tq, tp, o, mx, l); else att_compute<false>(blkP, blkC, qf, w, ql, g, tq, tp, o, mx, l);
    const float rl = 1.f / l, lse = mx + __builtin_amdgcn_logf(l);
    if (VAR == 1 || VAR == 4 || VAR == 5) { if (lse == 123.456f) WSP(float, WS_LSE)[0] = o[0][0] + o[1][1] + o[2][2] + o[3][3]; }
    else if (!MERGE) {
        bf16* OP = WSP(bf16, WS_OP) + (size_t)pat * MP * 512; float* LSE = WSP(float, WS_LSE) + (size_t)pat * MP * 8;
        v2u wv[4];
#pragma unroll
        for (int dv = 0; dv < 4; ++dv) { wv[dv].x = pk2(o[dv][0] * rl, o[dv][1] * rl); wv[dv].y = pk2(o[dv][2] * rl, o[dv][3] * rl); }
        st16_pair(OP + att_idx(qrow, h), 0, 1, wv[0], wv[1], g); st16_pair(OP + att_idx(qrow, h), 2, 3, wv[2], wv[3], g);
        if (g == 0) LSE[att_idx(qrow, h) >> 6] = lse;
    } else {
        ul16_pair(rawp0, mo0[0], mo0[1]); ul16_pair(rawp1, mo0[2], mo0[3]); ul16_pair(rawp2, mo1[0], mo1[1]); ul16_pair(rawp3, mo1[2], mo1[3]);
        const float M = fmaxf(fmaxf(l0, l1), lse);
        float w0 = __builtin_amdgcn_exp2f(l0 - M), w1 = __builtin_amdgcn_exp2f(l1 - M), w2 = __builtin_amdgcn_exp2f(lse - M);
        const float rw = 1.f / (w0 + w1 + w2); w0 *= rw; w1 *= rw; w2 *= rw * rl;
        bf16* MIX = WSP(bf16, WS_MIX); v2u wm[4];
#pragma unroll
        for (int dv = 0; dv < 4; ++dv) { const v2u a = mo0[dv], bq = mo1[dv];
            const float y0 = w0 * bflo(a.x) + w1 * bflo(bq.x) + w2 * o[dv][0], y1 = w0 * bfhi(a.x) + w1 * bfhi(bq.x) + w2 * o[dv][1];
            const float y2 = w0 * bflo(a.y) + w1 * bflo(bq.y) + w2 * o[dv][2], y3 = w0 * bfhi(a.y) + w1 * bfhi(bq.y) + w2 * o[dv][3];
            wm[dv].x = pk2(y0, y1); wm[dv].y = pk2(y2, y3); }
        st16_pair(MIX + qrow * 1024 + h * 64, 0, 1, wm[0], wm[1], g); st16_pair(MIX + qrow * 1024 + h * 64, 2, 3, wm[2], wm[3], g);
    }
    if (VAR != 4) { if (s + 1 < 16) { att_store(F, b, h, pat, s + 1, ST); qf[0] = ST.q[0]; qf[1] = ST.q[1]; } }
    __syncthreads();
}
template <bool MERGE, int VAR = 0>
__device__ __forceinline__ void attn_seq_unit(Frame& F, int b, int h, int pat) {
    if (VAR == 3) pat = 0;
    const int d = pat == 0 ? 1 : pat == 1 ? 4 : 16;
    AttPF A, B; bf16x8 qf[2];
    att_load(F, b, h, pat, d, 0, A); att_load(F, b, h, pat, d, 1, B);
    att_store(F, b, h, pat, 0, A); qf[0] = A.q[0]; qf[1] = A.q[1];
    __syncthreads();
    for (int s = 0; s < 16; s += 2) {
        attn_step<MERGE, VAR>(F, b, h, pat, d, s, A, B, qf);
        attn_step<MERGE, VAR>(F, b, h, pat, d, s + 1, B, A, qf);
    }
}

__device__ __forceinline__ float dpp_sum16(float x) {
    x += __builtin_bit_cast(float, __builtin_amdgcn_update_dpp(0, __builtin_bit_cast(int, x), 0xB1, 0xF, 0xF, true));
    x += __builtin_bit_cast(float, __builtin_amdgcn_update_dpp(0, __builtin_bit_cast(int, x), 0x4E, 0xF, 0xF, true));
    x += __builtin_bit_cast(float, __builtin_amdgcn_update_dpp(0, __builtin_bit_cast(int, x), 0x141, 0xF, 0xF, true));
    x += __builtin_bit_cast(float, __builtin_amdgcn_update_dpp(0, __builtin_bit_cast(int, x), 0x140, 0xF, 0xF, true));
    return x;
}
__device__ __forceinline__ void sattn_unit(Frame& F, int idx) {
    const int b = idx >> 2, t = idx & 3, lane = F.lane, hh = F.wave;
    const int R = MP + b * 4 + t;
    const bf16* Qb = WSP(bf16, WS_Q);
    const float* cK = F.in[2] + ((size_t)b * WINB * 512 + hh * 64); const float* cV = F.in[3] + ((size_t)b * WINB * 512 + hh * 64);
    const float* nK = F.out + O_KS + ((size_t)b * 4 * 512 + hh * 64); const float* nV = F.out + O_VS + ((size_t)b * 4 * 512 + hh * 64);
    const int ks = lane >> 4, c16 = lane & 15;
    float q4[4];
    { const v2u qw = *(const GAS v2u*)(Qb + att_idx(R, hh) + 4 * c16); q4[0] = bflo(qw.x); q4[1] = bfhi(qw.x); q4[2] = bflo(qw.y); q4[3] = bfhi(qw.y); }
    float mx = -1e30f, l = 0.f; float o4[4] = {0.f, 0.f, 0.f, 0.f};
#pragma unroll
    for (int pat = 0; pat < 3; ++pat) { const int d = pat == 0 ? 1 : pat == 1 ? 4 : 16;
#pragma unroll 1
        for (int ib = 0; ib < 3; ++ib) { f32x4 k4[11], v4[11]; float sv[11];
#pragma unroll
            for (int u = 0; u < 11; ++u) { const int i = 11 * ib + u; const int j = 4 * i + ks; const int jj = j <= 128 ? j : 128; const int rr = WINB + t - d * jj;
                const size_t ro = rr >= WINB ? (size_t)(rr - WINB) * 512 : (size_t)rr * 512;
                k4[u] = *(const GAS f32x4*)((rr >= WINB ? nK : cK) + ro + 4 * c16); v4[u] = *(const GAS f32x4*)((rr >= WINB ? nV : cV) + ro + 4 * c16); }
            float bm = -1e30f;
#pragma unroll
            for (int u = 0; u < 11; ++u) { const int i = 11 * ib + u; const bool valid = (4 * i + ks) <= 128;
                float part = dpp_sum16((q4[0] * k4[u][0] + q4[1] * k4[u][1]) + (q4[2] * k4[u][2] + q4[3] * k4[u][3]));
                part = valid ? part : -1e30f; sv[u] = part; bm = fmaxf(bm, part); }
            const float mn = fmaxf(mx, bm), rs = __builtin_amdgcn_exp2f(mx - mn); mx = mn;
            l *= rs; o4[0] *= rs; o4[1] *= rs; o4[2] *= rs; o4[3] *= rs;
#pragma unroll
            for (int u = 0; u < 11; ++u) { const float p = __builtin_amdgcn_exp2f(sv[u] - mx); l += p;
                o4[0] += p * v4[u][0]; o4[1] += p * v4[u][1]; o4[2] += p * v4[u][2]; o4[3] += p * v4[u][3]; } } }
    float M = fmaxf(mx, __shfl_xor(mx, 16)); M = fmaxf(M, __shfl_xor(M, 32));
    const float fs = __builtin_amdgcn_exp2f(mx - M); l *= fs;
    l += __shfl_xor(l, 16); l += __shfl_xor(l, 32);
    const float rl = 1.f / l;
#pragma unroll
    for (int k = 0; k < 4; ++k) { o4[k] *= fs; o4[k] += __shfl_xor(o4[k], 16); o4[k] += __shfl_xor(o4[k], 32); o4[k] *= rl; }
    if (ks == 0) { v2u wv; wv.x = pk2(o4[0], o4[1]); wv.y = pk2(o4[2], o4[3]); *(GAS v2u*)(WSP(bf16, WS_MIX) + (size_t)R * 1024 + hh * 64 + 4 * c16) = wv; }
}

__device__ __forceinline__ void smlstm_unit(Frame& F, int idx) {
    const int b = idx >> 2, h = idx & 3, tid = F.tid, lane = F.lane, w = F.wave;
    LAS float* qv = (LAS float*)(F.lds); LAS float* kv = qv + 512; LAS float* dots = kv + 512; LAS float* scal = dots + 32;
    LAS float* qcp = (LAS float*)(F.lds + 8192); LAS float* hsq = (LAS float*)(F.lds + 49152);
    const int R0 = MP + b * 4; const int bh = b * 4 + h;
    const bf16* MQ = WSP(bf16, WS_MQ); const bf16* MK = WSP(bf16, WS_MK); const bf16* MV = WSP(bf16, WS_MV); const bf16* MO = WSP(bf16, WS_MO); const float* G = WSP(float, WS_G);
    const float* C0 = F.in[4] + (size_t)bh * DK * DK; const float* n0 = F.in[5] + (size_t)bh * DK;
    { const int t = tid >> 7, j = tid & 127; const unsigned short q_ = MQ[ml_idx(R0 + t, h) + j], k_ = MK[ml_idx(R0 + t, h) + j]; asm volatile("" ::: "memory"); qv[tid] = bf2f(q_); kv[tid] = bf2f(k_); }
    __syncthreads();
    for (int di = w; di < 20; di += 8) { float x;
        if (di < 16) { const int t = di >> 2, s = di & 3; x = qv[t * 128 + lane] * kv[s * 128 + lane] + qv[t * 128 + lane + 64] * kv[s * 128 + lane + 64]; }
        else { const int t = di - 16; x = qv[t * 128 + lane] * n0[lane] + qv[t * 128 + lane + 64] * n0[lane + 64]; }
        x = wave_sum(x); if (lane == 0) dots[di] = x; }
    __syncthreads();
    if (tid == 0) {
        const float m0 = F.in[6][bh]; float lf[4], ig[4], bc[4];
#pragma unroll
        for (int t = 0; t < 4; ++t) { ig[t] = G[(size_t)(R0 + t) * 8 + h]; lf[t] = G[(size_t)(R0 + t) * 8 + 4 + h]; }
        bc[0] = lf[0]; bc[1] = bc[0] + lf[1]; bc[2] = bc[1] + lf[2]; bc[3] = bc[2] + lf[3];
#pragma unroll
        for (int t = 0; t < 4; ++t) { const float inter = bc[t] + m0; float mt = inter; float dd[4];
#pragma unroll
            for (int s = 0; s < 4; ++s) { dd[s] = bc[t] - bc[s] + ig[s]; if (s <= t) mt = fmaxf(mt, dd[s]); }
            float den = 0.f;
#pragma unroll
            for (int s = 0; s < 4; ++s) { const float a = (s <= t) ? expf(dd[s] - mt) * dots[t * 4 + s] : 0.f; scal[t * 4 + s] = a; den += a; }
            const float wi = expf(inter - mt); den += wi * dots[16 + t]; den = fmaxf(fabsf(den), expf(-mt));
            scal[16 + t] = wi; scal[20 + t] = 1.f / den; }
        const float bl = bc[3]; float mn = bl + m0; float gs[4];
#pragma unroll
        for (int s = 0; s < 4; ++s) { gs[s] = bl - bc[s] + ig[s]; mn = fmaxf(mn, gs[s]); }
#pragma unroll
        for (int s = 0; s < 4; ++s) scal[24 + s] = expf(gs[s] - mn);
        scal[28] = expf(bl + m0 - mn);
        F.out[O_MS + bh] = mn;
    }
    __syncthreads();
    {
        const int vq = tid & 31, kg = tid >> 5; LAS float* vls = (LAS float*)(F.lds + 4608);
        f32x4 c4[8];
#pragma unroll
        for (int kk = 0; kk < 8; ++kk) c4[kk] = *(const GAS f32x4*)(C0 + (size_t)(8 * kg + kk) * 128 + 4 * vq);
        f32x4 wsv[4]; v2u mvw[4];
#pragma unroll
        for (int s = 0; s < 4; ++s) mvw[s] = *(const GAS v2u*)(MV + ml_idx(R0 + s, h) + 4 * vq);
        asm volatile("" ::: "memory");
#pragma unroll
        for (int s = 0; s < 4; ++s) { const v2u w = mvw[s]; const f32x4 vv = {bflo(w.x), bfhi(w.x), bflo(w.y), bfhi(w.y)};
            if (kg == 0) *(LAS f32x4*)(vls + s * 128 + 4 * vq) = vv; wsv[s] = vv * scal[24 + s]; }
        const float wc = scal[28];
        f32x4 qc[4];
#pragma unroll
        for (int t = 0; t < 4; ++t) qc[t] = (f32x4){0.f, 0.f, 0.f, 0.f};
        float* Cout = F.out + O_CS + (size_t)bh * DK * DK;
#pragma unroll
        for (int kk = 0; kk < 8; ++kk) { const int k = 8 * kg + kk;
#pragma unroll
            for (int t = 0; t < 4; ++t) qc[t] += c4[kk] * qv[t * 128 + k];
            const f32x4 cn = c4[kk] * wc + (wsv[0] * kv[k] + wsv[1] * kv[128 + k]) + (wsv[2] * kv[256 + k] + wsv[3] * kv[384 + k]);
            *(GAS f32x4*)(Cout + (size_t)k * 128 + 4 * vq) = cn; }
#pragma unroll
        for (int t = 0; t < 4; ++t) *(LAS f32x4*)(qcp + (kg * 4 + t) * 128 + 4 * vq) = qc[t];
        if (tid < 128) F.out[O_NS + (size_t)bh * DK + tid] = wc * n0[tid] + (scal[24] * kv[tid] + scal[25] * kv[128 + tid]) + (scal[26] * kv[256 + tid] + scal[27] * kv[384 + tid]);
    }
    __syncthreads();
    { const int v = tid & 127, t = tid >> 7; LAS float* vls = (LAS float*)(F.lds + 4608);
        float num = (scal[t * 4 + 0] * vls[v] + scal[t * 4 + 1] * vls[128 + v]) + (scal[t * 4 + 2] * vls[256 + v] + scal[t * 4 + 3] * vls[384 + v]);
        float qs = 0.f;
#pragma unroll
        for (int kg = 0; kg < 16; ++kg) qs += qcp[(kg * 4 + t) * 128 + v];
        num += scal[16 + t] * qs;
        const float hv = num * scal[20 + t];
        const float sq = wave_sum(hv * hv); if (lane == 0) hsq[w] = sq;
        __syncthreads();
        const float tot = hsq[2 * t] + hsq[2 * t + 1];
        const float inv = __builtin_amdgcn_rsqf(tot * (1.f / 128.f) + EPS);
        const float y = hv * inv * F.in[17][h * 128 + v] * bf2f(MO[ml_idx(R0 + t, h) + v]);
        WSP(bf16, WS_MIX)[(size_t)(R0 + t) * 1024 + 512 + h * 128 + v] = (bf16)(pk2(y, 0.f) & 0xffffu);
    }
    __syncthreads();
}

constexpr int MKS = 272;
__device__ __forceinline__ void mlstm1_unit(Frame& F, int bh) {
    const int b = bh >> 2, h = bh & 3, tid = F.tid, lane = F.lane, w = F.wave;
    LAS unsigned char* Ks = F.lds; LAS unsigned char* Vs = F.lds + 128 * MKS;
    LAS float* wsv = (LAS float*)(F.lds + 2 * 128 * MKS); LAS float* blv = wsv + 2048; LAS float* gmv = blv + 16; LAS float* mvec = gmv + 16; LAS float* wcv = mvec + 32; LAS float* npart = wcv + 16;
    const float* G = WSP(float, WS_G); const bf16* MK = WSP(bf16, WS_MK); const bf16* MV = WSP(bf16, WS_MV);
    const size_t row0 = (size_t)b * SEQ;
    {
        float lf[4], ig[4], cs[4];
#pragma unroll
        for (int j = 0; j < 4; ++j) { ig[j] = G[(row0 + 4 * tid + j) * 8 + h]; lf[j] = G[(row0 + 4 * tid + j) * 8 + 4 + h]; }
        cs[0] = lf[0]; cs[1] = cs[0] + lf[1]; cs[2] = cs[1] + lf[2]; cs[3] = cs[2] + lf[3];
        float x = cs[3];
#pragma unroll
        for (int off = 1; off < 32; off <<= 1) { const float y = __shfl_up(x, off, 32); if ((lane & 31) >= off) x += y; }
        const float excl = x - cs[3]; const float bl = __shfl(x, 31, 32);
        float gj[4], gm = -1e30f;
#pragma unroll
        for (int j = 0; j < 4; ++j) { gj[j] = bl - (excl + cs[j]) + ig[j]; gm = fmaxf(gm, gj[j]); }
#pragma unroll
        for (int off = 1; off < 32; off <<= 1) gm = fmaxf(gm, __shfl_xor(gm, off));
        const int ch = tid >> 5;
        if ((lane & 31) == 0) { blv[ch] = bl; gmv[ch] = gm; }
        __syncthreads();
        if (tid == 0) { float m = 0.f; mvec[0] = 0.f;
            for (int c = 0; c < 16; ++c) { const float mn = fmaxf(blv[c] + m, gmv[c]); wcv[c] = expf(blv[c] + m - mn); m = mn; mvec[c + 1] = m; } }
        __syncthreads();
        const float mnew = mvec[ch + 1];
#pragma unroll
        for (int j = 0; j < 4; ++j) wsv[4 * tid + j] = expf(gj[j] - mnew);
        if (tid < 16) WSP(float, WS_MC)[bh * 16 + tid] = mvec[tid];
        if (tid == 16) F.out[O_MP + bh] = mvec[16];
    }
    __syncthreads();
    const int ql = lane & 15, g = lane >> 4, tq = (lane & 15) >> 2, tp = lane & 3, dkg = w >> 1, dvg = w & 1;
    f32x4 acc[2][4];
#pragma unroll
    for (int a = 0; a < 2; ++a)
#pragma unroll
        for (int q = 0; q < 4; ++q) acc[a][q] = (f32x4){0.f, 0.f, 0.f, 0.f};
    float nacc = 0.f;
    bf16* CTg = WSP(bf16, WS_CT); float* NCg = WSP(float, WS_NC);
    v4u pkx[4], pvx[4];
#pragma unroll
    for (int p = 0; p < 4; ++p) { const int id = p * 512 + tid, rr = id >> 4, ch = id & 15; const size_t ge = ml_idx(row0 + rr, h) + ch * 8; pkx[p] = *(const GAS v4u*)(MK + ge); pvx[p] = *(const GAS v4u*)(MV + ge); }
    for (int c = 0; c < 16; ++c) {
#pragma unroll
        for (int a = 0; a < 2; ++a)
#pragma unroll
            for (int q = 0; q < 4; ++q) { const int dk0 = 16 * (2 * dkg + a) + 4 * g, dv = 16 * (4 * dvg + q) + ql;
                v2u wv; wv.x = pk2(acc[a][q][0], acc[a][q][1]); wv.y = pk2(acc[a][q][2], acc[a][q][3]);
                *(GAS v2u*)(CTg + ((size_t)(bh * 16 + c) * 128 + dv) * 128 + dk0) = wv; }
        if (tid < 128) NCg[(size_t)(bh * 16 + c) * 128 + tid] = nacc;
#pragma unroll
        for (int p = 0; p < 4; ++p) { const int id = p * 512 + tid, rr = id >> 4, ch = id & 15;
            const v4u kx = pkx[p]; v4u vx = pvx[p]; const float ws = wsv[128 * c + rr];
            vx.x = pk2(bflo(vx.x) * ws, bfhi(vx.x) * ws); vx.y = pk2(bflo(vx.y) * ws, bfhi(vx.y) * ws); vx.z = pk2(bflo(vx.z) * ws, bfhi(vx.z) * ws); vx.w = pk2(bflo(vx.w) * ws, bfhi(vx.w) * ws);
            *(LAS v4u*)(Ks + rr * MKS + ch * 16) = kx; *(LAS v4u*)(Vs + rr * MKS + ch * 16) = vx; }
        __syncthreads();
        if (c < 15) {
#pragma unroll
            for (int p = 0; p < 4; ++p) { const int id = p * 512 + tid, rr = id >> 4, ch = id & 15; const size_t ge = ml_idx(row0 + 128 * (c + 1) + rr, h) + ch * 8; pkx[p] = *(const GAS v4u*)(MK + ge); pvx[p] = *(const GAS v4u*)(MV + ge); } }
        {
            const int dk = tid & 127, sq = tid >> 7; float part = 0.f;
#pragma unroll 8
            for (int s = 32 * sq; s < 32 * sq + 32; ++s) part += wsv[128 * c + s] * bf2f(*(const LAS unsigned short*)(Ks + s * MKS + dk * 2));
            npart[sq * 128 + dk] = part; }
        const float wcc = wcv[c];
#pragma unroll
        for (int a = 0; a < 2; ++a)
#pragma unroll
            for (int q = 0; q < 4; ++q) acc[a][q] = acc[a][q] * wcc;
#pragma unroll
        for (int ks = 0; ks < 4; ++ks) { bf16x8 af[2], bfr[4];
            const int r0 = 32 * ks + 8 * g + tq;
#pragma unroll
            for (int a = 0; a < 2; ++a) { const int col = 16 * (2 * dkg + a) + 4 * tp; af[a] = cat4(ds_tr(Ks + r0 * MKS + col * 2), ds_tr(Ks + (r0 + 4) * MKS + col * 2)); }
#pragma unroll
            for (int q = 0; q < 4; ++q) { const int col = 16 * (4 * dvg + q) + 4 * tp; bfr[q] = cat4(ds_tr(Vs + r0 * MKS + col * 2), ds_tr(Vs + (r0 + 4) * MKS + col * 2)); }
#pragma unroll
            for (int a = 0; a < 2; ++a)
#pragma unroll
                for (int q = 0; q < 4; ++q) acc[a][q] = mfma16(af[a], bfr[q], acc[a][q]); }
        __syncthreads();
        if (tid < 128) nacc = wcc * nacc + ((npart[tid] + npart[128 + tid]) + (npart[256 + tid] + npart[384 + tid]));
    }
    float* Cout = F.out + O_CP + (size_t)bh * DK * DK;
#pragma unroll
    for (int a = 0; a < 2; ++a)
#pragma unroll
        for (int q = 0; q < 4; ++q) { const int dk0 = 16 * (2 * dkg + a) + 4 * g, dv = 16 * (4 * dvg + q) + ql;
#pragma unroll
            for (int e = 0; e < 4; ++e) Cout[(size_t)(dk0 + e) * 128 + dv] = acc[a][q][e]; }
    if (tid < 128) F.out[O_NP + (size_t)bh * DK + tid] = nacc;
    __syncthreads();
}

__device__ __forceinline__ void ml2_issue(Frame& F, int idx, v4u (&sk)[4], v4u (&sv)[4], v4u (&sc4)[4]) {
    const int bh = idx >> 4, c = idx & 15, b = bh >> 2, h = bh & 3, tid = F.tid;
    const bf16* MK = WSP(bf16, WS_MK); const bf16* MV = WSP(bf16, WS_MV); const bf16* CTg = WSP(bf16, WS_CT) + (size_t)(bh * 16 + c) * DK * DK;
    const size_t row0 = (size_t)b * SEQ + 128 * c;
#pragma unroll
    for (int p = 0; p < 4; ++p) { const int id = p * 512 + tid, rr = id >> 4, ch = id & 15; const size_t ge = ml_idx(row0 + rr, h) + ch * 8;
        sk[p] = *(const GAS v4u*)(MK + ge); sv[p] = *(const GAS v4u*)(MV + ge); sc4[p] = *(const GAS v4u*)(CTg + (size_t)rr * 128 + ch * 8); }
    asm volatile("" ::: "memory");
}
__device__ __forceinline__ void mlstm2_seq(Frame& F, int idx0, int stride, int nunits) {
    v4u sk[4], sv[4], sc4[4];
    if (idx0 < nunits) ml2_issue(F, idx0, sk, sv, sc4);
    for (int idx = idx0; idx < nunits; idx += stride) {
    const int bh = idx >> 4, c = idx & 15, b = bh >> 2, h = bh & 3, tid = F.tid, lane = F.lane, w = F.wave;
    LAS unsigned char* Ks = F.lds; LAS unsigned char* Vs = F.lds + 128 * MKS; LAS unsigned char* Cs = F.lds + 2 * 128 * MKS;
    LAS float* bvec = (LAS float*)(F.lds + 3 * 128 * MKS); LAS float* avec = bvec + 128; LAS float* mtv = avec + 128; LAS float* nvec = mtv + 128;
    const float* G = WSP(float, WS_G); const bf16* MQ = WSP(bf16, WS_MQ); const bf16* MK = WSP(bf16, WS_MK); const bf16* MV = WSP(bf16, WS_MV); const bf16* MO = WSP(bf16, WS_MO);
    const bf16* CTg = WSP(bf16, WS_CT) + (size_t)(bh * 16 + c) * DK * DK; const float* NCg = WSP(float, WS_NC) + (size_t)(bh * 16 + c) * DK;
    const size_t row0 = (size_t)b * SEQ + 128 * c;
    const float mc = WSP(float, WS_MC)[bh * 16 + c];
    {
#pragma unroll
        for (int p = 0; p < 4; ++p) { const int id = p * 512 + tid, rr = id >> 4, ch = id & 15;
            *(LAS v4u*)(Ks + rr * MKS + ch * 16) = sk[p]; *(LAS v4u*)(Vs + rr * MKS + ch * 16) = sv[p]; *(LAS v4u*)(Cs + rr * MKS + ch * 16) = sc4[p]; } }
    if (w == 0) {
        const int s0 = 2 * lane;
        const float lf0 = G[(row0 + s0) * 8 + 4 + h], lf1 = G[(row0 + s0 + 1) * 8 + 4 + h], ig0 = G[(row0 + s0) * 8 + h], ig1 = G[(row0 + s0 + 1) * 8 + h];
        float x = lf0 + lf1;
#pragma unroll
        for (int off = 1; off < 64; off <<= 1) { const float y = __shfl_up(x, off); if (lane >= off) x += y; }
        const float b1 = x, b0 = x - lf1; const float a0 = ig0 - b0, a1 = ig1 - b1;
        float pm = fmaxf(a0, a1);
#pragma unroll
        for (int off = 1; off < 64; off <<= 1) { const float y = __shfl_up(pm, off); if (lane >= off) pm = fmaxf(pm, y); }
        float pe = __shfl_up(pm, 1); if (lane == 0) pe = -1e30f;
        const float pm0 = fmaxf(pe, a0), pm1 = pm;
        const float L2E = 1.4426950408889634f;
        bvec[s0] = b0 * L2E; bvec[s0 + 1] = b1 * L2E; avec[s0] = a0 * L2E; avec[s0 + 1] = a1 * L2E; mtv[s0] = (b0 + fmaxf(mc, pm0)) * L2E; mtv[s0 + 1] = (b1 + fmaxf(mc, pm1)) * L2E;
    }
    if (w == 1) { const float n0_ = NCg[lane], n1_ = NCg[lane + 64]; asm volatile("" ::: "memory"); nvec[lane] = n0_; nvec[lane + 64] = n1_; }
    const int ql = lane & 15, g = lane >> 4, tq = (lane & 15) >> 2, tp = lane & 3;
    const int t = 16 * w + ql; const size_t row = row0 + t;
    bf16x8 qf[4];
#pragma unroll
    for (int kk = 0; kk < 4; ++kk) qf[kk] = *(const GAS bf16x8*)(MQ + ml_idx(row, h) + 32 * kk + 8 * g);
    __syncthreads();
    const float mtt = mtv[t], et = bvec[t] - mtt, winter = __builtin_amdgcn_exp2f(et + mc * 1.4426950408889634f);
    f32x4 st[8]; float dsum = 0.f;
#pragma unroll
    for (int js = 0; js < 8; ++js) { st[js] = (f32x4){0.f, 0.f, 0.f, 0.f};
        if (js <= w) { f32x4 a = {0.f, 0.f, 0.f, 0.f};
#pragma unroll
            for (int kk = 0; kk < 4; ++kk) { const bf16x8 kf = *(const LAS bf16x8*)(Ks + (16 * js + ql) * MKS + 64 * kk + 16 * g); a = mfma16(kf, qf[kk], a); }
            const f32x4 av = *(const LAS f32x4*)(avec + 16 * js + 4 * g);
#pragma unroll
            for (int e = 0; e < 4; ++e) { const int s = 16 * js + 4 * g + e; const float val = (s <= t) ? __builtin_amdgcn_exp2f(et + av[e]) * a[e] : 0.f; st[js][e] = val; dsum += val; } } }
    dsum += __shfl_xor(dsum, 16); dsum += __shfl_xor(dsum, 32);
    float qn = 0.f;
#pragma unroll
    for (int kk = 0; kk < 4; ++kk) { const f32x4 n0 = *(const LAS f32x4*)(nvec + 32 * kk + 8 * g), n1 = *(const LAS f32x4*)(nvec + 32 * kk + 8 * g + 4);
        qn += (bf2f((unsigned short)qf[kk][0]) * n0[0] + bf2f((unsigned short)qf[kk][1]) * n0[1]) + (bf2f((unsigned short)qf[kk][2]) * n0[2] + bf2f((unsigned short)qf[kk][3]) * n0[3])
            + (bf2f((unsigned short)qf[kk][4]) * n1[0] + bf2f((unsigned short)qf[kk][5]) * n1[1]) + (bf2f((unsigned short)qf[kk][6]) * n1[2] + bf2f((unsigned short)qf[kk][7]) * n1[3]); }
    qn += __shfl_xor(qn, 16); qn += __shfl_xor(qn, 32);
    float den = dsum + winter * qn; den = fmaxf(fabsf(den), __builtin_amdgcn_exp2f(-mtt));
    f32x4 o[8];
#pragma unroll
    for (int dv = 0; dv < 8; ++dv) o[dv] = (f32x4){0.f, 0.f, 0.f, 0.f};
#pragma unroll
    for (int jp = 0; jp < 4; ++jp) if (2 * jp <= w) { const bf16x8 pf = pack8f(st[2 * jp], st[2 * jp + 1]); const int r0 = 32 * jp + 4 * g + tq;
#pragma unroll
        for (int dv = 0; dv < 8; ++dv) { const int col = 16 * dv + 4 * tp; o[dv] = mfma16(cat4(ds_tr(Vs + r0 * MKS + col * 2), ds_tr(Vs + (r0 + 16) * MKS + col * 2)), pf, o[dv]); } }
    f32x4 gvv[8]; v2u mov[8];
    { const float* gn_ = F.in[17] + h * 128;
#pragma unroll
        for (int dv = 0; dv < 8; ++dv) { const int col = 16 * dv + 4 * g; gvv[dv] = *(const GAS f32x4*)(gn_ + col); mov[dv] = *(const GAS v2u*)(MO + ml_idx(row, h) + col); } }
    bf16x8 qs[4];
#pragma unroll
    for (int kk = 0; kk < 4; ++kk) { f32x4 lo, hi;
#pragma unroll
        for (int e = 0; e < 4; ++e) { lo[e] = bf2f((unsigned short)qf[kk][e]) * winter; hi[e] = bf2f((unsigned short)qf[kk][4 + e]) * winter; }
        qs[kk] = pack8f(lo, hi); }
#pragma unroll
    for (int dv = 0; dv < 8; ++dv)
#pragma unroll
        for (int kk = 0; kk < 4; ++kk) { const bf16x8 cf = *(const LAS bf16x8*)(Cs + (16 * dv + ql) * MKS + 64 * kk + 16 * g); o[dv] = mfma16(cf, qs[kk], o[dv]); }
    asm volatile("" ::: "memory");
    if (idx + stride < nunits) ml2_issue(F, idx + stride, sk, sv, sc4);
    const float rden = 1.f / den; float ssq = 0.f;
#pragma unroll
    for (int dv = 0; dv < 8; ++dv) { o[dv] = o[dv] * rden; ssq += (o[dv][0] * o[dv][0] + o[dv][1] * o[dv][1]) + (o[dv][2] * o[dv][2] + o[dv][3] * o[dv][3]); }
    ssq += __shfl_xor(ssq, 16); ssq += __shfl_xor(ssq, 32);
    const float inv = __builtin_amdgcn_rsqf(ssq * (1.f / 128.f) + EPS);
    bf16* MIX = WSP(bf16, WS_MIX); const float* gn = F.in[17] + h * 128; v2u wm[8];
#pragma unroll
    for (int dv = 0; dv < 8; ++dv) { const int col = 16 * dv + 4 * g; const f32x4 gv = gvv[dv]; const v2u mo = mov[dv];
        const float y0 = o[dv][0] * inv * gv[0] * bflo(mo.x), y1 = o[dv][1] * inv * gv[1] * bfhi(mo.x), y2 = o[dv][2] * inv * gv[2] * bflo(mo.y), y3 = o[dv][3] * inv * gv[3] * bfhi(mo.y);
        wm[dv].x = pk2(y0, y1); wm[dv].y = pk2(y2, y3); }
#pragma unroll
    for (int dp = 0; dp < 4; ++dp) st16_pair(MIX + row * 1024 + 512 + h * 128, 2 * dp, 2 * dp + 1, wm[2 * dp], wm[2 * dp + 1], g);
    __syncthreads();
    }
}


constexpr int N_PHASES = 9;
constexpr int U4_ML1 = 128, U4_SATT = 512, U4_SML = 512, U4_ATT = 512;
constexpr int U5_ML2 = 2048, U5_ATT = 256;

__device__ __forceinline__ int queue_next(Frame& F, int word) {
    __syncthreads();
    if (F.tid == 0) F.MISC[4] = __hip_atomic_fetch_add((unsigned*)(F.ctl + word), 1u, RLX_AGENT);
    __syncthreads();
    return __builtin_amdgcn_readfirstlane((int)F.MISC[4]);
}

template <int MODE, int nS> __device__ __forceinline__ void reduce_tail(Frame& F, float alpha) {
    const float* SLAB = WSP(float, WS_SLAB); bf16* XB = WSP(bf16, WS_XB); const float* SS = WSP(float, WS_SS); float* RS = WSP(float, WS_RS);
    for (int rr = (int)blockIdx.x * 2; rr < MS; rr += F.G * 2) { const int row = rr + (F.tid >> 8), col = (F.tid & 255) * 4;
        f32x4 a = {0.f, 0.f, 0.f, 0.f};
        v2u sw[nS];
#pragma unroll
        for (int ks = 0; ks < nS; ++ks) sw[ks] = *(const GAS v2u*)((const bf16*)SLAB + ((size_t)ks * 512 + row) * 1024 + col);
#pragma unroll
        for (int ks = 0; ks < nS; ++ks) a += (f32x4){bflo(sw[ks].x), bfhi(sw[ks].x), bflo(sw[ks].y), bfhi(sw[ks].y)};
        f32x4 res;
        if (MODE == 0) res = *(const GAS f32x4*)(F.in[1] + (size_t)row * 1024 + col);
        else { const v2u w = *(const GAS v2u*)(XB + (size_t)(MP + row) * 1024 + col); res = (f32x4){bflo(w.x), bfhi(w.x), bflo(w.y), bfhi(w.y)}; }
        const f32x4 v = res + a * alpha;
        if (MODE == 2) *(GAS f32x4*)(F.out + O_Y + (size_t)(MP + row) * 1024 + col) = v;
        else { v2u w; w.x = pk2(v[0], v[1]); w.y = pk2(v[2], v[3]); *(GAS v2u*)(XB + (size_t)(MP + row) * 1024 + col) = w;
            if (MODE == 1) { int q = 0; q = __builtin_amdgcn_cvt_pk_fp8_f32(__builtin_amdgcn_fmed3f(v[0] * 16.f, -448.f, 448.f), __builtin_amdgcn_fmed3f(v[1] * 16.f, -448.f, 448.f), q, false);
                q = __builtin_amdgcn_cvt_pk_fp8_f32(__builtin_amdgcn_fmed3f(v[2] * 16.f, -448.f, 448.f), __builtin_amdgcn_fmed3f(v[3] * 16.f, -448.f, 448.f), q, true);
                *(GAS unsigned*)(WSP(unsigned char, WS_X8) + (size_t)(MP + row) * 1024 + col) = (unsigned)q; }
            const float ss = wave_sum((v[0] * v[0] + v[1] * v[1]) + (v[2] * v[2] + v[3] * v[3]));
            LAS float* red = (LAS float*)F.lds;
            __syncthreads(); if (F.lane == 0) red[F.wave] = ss; __syncthreads();
            if ((F.tid & 255) == 0) { const int w0 = F.wave; RS[MP + row] = __builtin_amdgcn_rsqf(((red[w0] + red[w0 + 1]) + (red[w0 + 2] + red[w0 + 3])) * (1.f / 1024.f) + EPS); } }
    }
    if (MODE != 2) {
        for (int row = (int)blockIdx.x * 512 + F.tid; row < MP; row += F.G * 512) { const GAS f32x4* p = (const GAS f32x4*)(SS + (size_t)row * 16); const f32x4 a = p[0], b = p[1], c = p[2], d = p[3];
            const float s = ((a[0] + a[1]) + (a[2] + a[3])) + ((b[0] + b[1]) + (b[2] + b[3])) + ((c[0] + c[1]) + (c[2] + c[3])) + ((d[0] + d[1]) + (d[2] + d[3]));
            RS[row] = __builtin_amdgcn_rsqf(s * (1.f / 1024.f) + EPS); }
    }
}

__device__ __forceinline__ void ctl_publish(Frame& F, int word) {
    __builtin_amdgcn_s_waitcnt(0x0F70); asm volatile("" ::: "memory");
    __syncthreads();
    if (F.tid == 0) { __builtin_amdgcn_fence(__ATOMIC_RELEASE, "agent"); asm volatile("s_waitcnt vmcnt(0)" ::: "memory");
        (void)__hip_atomic_fetch_add((unsigned*)(F.ctl + word), 1u, RLX_AGENT); }
}
__device__ __forceinline__ void ctl_acquire(Frame& F, int word, unsigned need) {
    __syncthreads();
    if (F.tid == 0) { unsigned v = __hip_atomic_load((unsigned*)(F.ctl + word), RLX_AGENT);
        unsigned sp = 0; while (v < need && sp < (1u << 22)) { __builtin_amdgcn_s_sleep(2); ++sp; v = __hip_atomic_load((unsigned*)(F.ctl + word), RLX_AGENT); }
        __builtin_amdgcn_fence(__ATOMIC_ACQUIRE, "agent"); asm volatile("s_waitcnt vmcnt(0)" ::: "memory"); }
    __syncthreads();
}

constexpr int N_SUNITS = 2 * (INP / 256);
__device__ __forceinline__ void sample_publish(Frame& F) {
    __builtin_amdgcn_s_waitcnt(0x0F70); asm volatile("" ::: "memory");
    __syncthreads();
    if (F.tid == 0) { __builtin_amdgcn_fence(__ATOMIC_RELEASE, "agent"); asm volatile("s_waitcnt vmcnt(0)" ::: "memory");
        (void)__hip_atomic_fetch_add((unsigned*)(F.ctl + CW_SDONE), 1u, RLX_AGENT); }
}
__device__ __forceinline__ bool sample_acquire(Frame& F, bool block) {
    __syncthreads();
    if (F.tid == 0) { unsigned v = __hip_atomic_load((unsigned*)(F.ctl + CW_SDONE), RLX_AGENT);
        if (block) { unsigned sp = 0; while (v < (unsigned)N_SUNITS && sp < (1u << 20)) { __builtin_amdgcn_s_sleep(2); ++sp; v = __hip_atomic_load((unsigned*)(F.ctl + CW_SDONE), RLX_AGENT); } }
        __builtin_amdgcn_fence(__ATOMIC_ACQUIRE, "agent"); asm volatile("s_waitcnt vmcnt(0)" ::: "memory");
        F.MISC[6] = v; }
    __syncthreads();
    return __builtin_amdgcn_readfirstlane((int)F.MISC[6]) >= N_SUNITS;
}

struct Args { const float* in[23]; float* out; unsigned char* ws; int ph_lo, ph_hi; };
__global__ void __launch_bounds__(NWAVES * 64, 2) hymba_fwd(Args args) {
    extern __shared__ __attribute__((aligned(16))) unsigned char lds[];
    Frame F;
    F.lds = (LAS unsigned char*)lds;
    F.MISC = (volatile LAS unsigned*)(F.lds + MISC_OFF);
    F.tid = threadIdx.x; F.lane = F.tid & 63; F.wave = __builtin_amdgcn_readfirstlane(F.tid >> 6);
    F.G = gridDim.x;
    F.ws = args.ws; F.out = args.out;
#pragma unroll
    for (int i = 0; i < 23; ++i) F.in[i] = args.in[i];
    F.ctl = (gu32*)(F.ws + WS_CTL);
    for (int u = F.tid; u < (LDS_BYTES - LDSCTL_OFF) / 4; u += NWAVES * 64) ((LAS unsigned*)(F.lds + LDSCTL_OFF))[u] = 0u;
    __syncthreads();
    const int lo = args.ph_lo, hi = args.ph_hi;
    const bool multi = (hi - lo) > 1;
    XcdBarrier bar; bar.bar = (unsigned*)(F.ctl + CW_BAR); bar.x = 0; bar.st = nullptr;
    if (multi) bar = xcd_barrier_post((unsigned*)(F.ctl + CW_BAR), F.MISC + 8);
#ifdef PH_ONLY
#define IN(k) ((k) == PH_ONLY && lo <= (k) && (k) < hi)
#else
#define IN(k) (lo <= (k) && (k) < hi)
#endif
#define SEAM(k) do { if (IN(k) && IN((k) + 1)) xcd_barrier(bar); } while (0)
    constexpr bool AL = true, SP = true;
#ifndef REP_PH
#define REP_PH -1
#endif
#ifndef REP_PH2
#define REP_PH2 -1
#endif

    const unsigned my_xcc = xb_xcc_id() & 7u;
    if (F.tid == 0) F.MISC[5] = __hip_atomic_fetch_add((unsigned*)(F.ctl + CW_XR + 64 * my_xcc), 1u, RLX_AGENT);
    constexpr int N_P1S = 2 * (NGU / 256);
    constexpr int P0_RA = 11136;
    const bool p1s_in_p0 = F.G >= 4 * N_P1S;
    if (IN(0)) {
        const int bw = (int)blockIdx.x;
        p0_part<0>(F, bw * NWAVES + F.wave, F.G * NWAVES);
        if (p1s_in_p0) {
            ctl_publish(F, CW_P0A);
            if (bw < N_P1S) {
                ctl_acquire(F, CW_P0A, (unsigned)F.G);
                pg8::Gemm g{WSP(bf16, WS_XB), WSP(bf16, WS_WGU1), MT, NGU, D}; pg8::OneUnitOrder S; S.pm = 256 + bw / (NGU / 256); S.pn = bw % (NGU / 256); S.ntk = D / 64; S.has = true;
                pg8::EpiGateUp<false> E{WSP(bf16, WS_ACT), WSP(float, WS_RS), 1.0f};
                pg8::gemm_phase<pg8::EpiGateUp<false>, pg8::OneUnitOrder, AL, SP>(F.lds, g, S, E);
            } else { p0_part<1>(F, (bw - N_P1S) * NWAVES + F.wave, (F.G - N_P1S) * NWAVES); p0_rows(F, 0, P0_RA, (bw - N_P1S) * NWAVES + F.wave, (F.G - N_P1S) * NWAVES); }
            p0_rows(F, P0_RA, MP, bw * NWAVES + F.wave, F.G * NWAVES);
        } else { __syncthreads(); p0_part<1>(F, bw * NWAVES + F.wave, F.G * NWAVES); p0_rows(F, 0, MP, bw * NWAVES + F.wave, F.G * NWAVES); }
        SEAM(0);
    }

    int vc = (int)blockIdx.x;
    if (multi) { bool even = (F.G % 8) == 0;
        unsigned cen[8];
#pragma unroll
        for (int j = 0; j < 8; ++j) cen[j] = __hip_atomic_load((unsigned*)(F.ctl + CW_XR + 64 * j), RLX_AGENT);
#pragma unroll
        for (int j = 0; j < 8; ++j) even = even & (cen[j] == (unsigned)(F.G / 8));
        const int rk = (int)F.MISC[5];
        if (even && rk < F.G / 8) vc = rk * 8 + (int)my_xcc; }
    vc = __builtin_amdgcn_readfirstlane(vc);
    if (IN(1)) {
        pg8::Gemm g{WSP(bf16, WS_XB), WSP(bf16, WS_WGU1), MT, NGU, D}; pg8::StaticOrder S; S.init(p1s_in_p0 ? MP : MT, NGU, F.G, vc, D);
        pg8::EpiGateUp<false> E{WSP(bf16, WS_ACT), WSP(float, WS_RS), 1.0f};
        pg8::gemm_phase<pg8::EpiGateUp<false>, pg8::StaticOrder, AL, SP>(F.lds, g, S, E); SEAM(1);
#if REP_PH == 1 || REP_PH2 == 1
        pg8::gemm_phase<pg8::EpiGateUp<false>, pg8::StaticOrder, AL, SP>(F.lds, g, S, E); SEAM(1);
#endif
#if defined(NULL_PH1)
        { pg8::EpiNull EN; pg8::gemm_phase<pg8::EpiNull, pg8::StaticOrder, AL, SP>(F.lds, g, S, EN); SEAM(1); }
#endif
#if defined(SAME_PH1)
        { pg8::EpiNull EN; pg8::SameTileOrder SS_; SS_.nr = 23; SS_.c = (int)blockIdx.x; SS_.ntk = 16; pg8::gemm_phase<pg8::EpiNull, pg8::SameTileOrder, AL, SP>(F.lds, g, SS_, EN); SEAM(1); }
#endif
    }
    if (IN(2)) {
        pg8::Gemm g{WSP(bf16, WS_ACT), WSP(bf16, WS_WD1), MT, D, FF}; pg8::TailSplitOrder S; S.init(D, F.G, vc, FF, 4);
        typedef pg8::EpiResid<3> E_t; E_t E{nullptr, nullptr, nullptr, WSP(bf16, WS_XB), WSP(float, WS_SS), WSP(float, WS_SLAB), 0.5f, nullptr};
        pg8::gemm_phase<E_t, pg8::TailSplitOrder, AL, SP>(F.lds, g, S, E); xcd_barrier(bar); reduce_tail<3, 11>(F, 0.5f); SEAM(2);
#if REP_PH == 2 || REP_PH2 == 2
        pg8::gemm_phase<E_t, pg8::TailSplitOrder, AL, SP>(F.lds, g, S, E); xcd_barrier(bar); reduce_tail<3, 11>(F, 0.5f); SEAM(2);
#endif
#if defined(NULL_PH2)
        { pg8::EpiNull EN; pg8::gemm_phase<pg8::EpiNull, pg8::TailSplitOrder, AL, SP>(F.lds, g, S, EN); SEAM(2); }
#endif
    }
    if (IN(3)) {
        pg8::Gemm g{WSP(bf16, WS_XB), WSP(bf16, WS_WIN), MT, INP, D}; pg8::StaticOrder S; S.init(MP, INP, F.G, vc, D);
        pg8::EpiIn<0> E{WSP(float, WS_RS), WSP(float, WS_ROPE), F.in[13], F.in[14], F.in[15], F.in[16],
                     WSP(bf16, WS_Q), WSP(bf16, WS_K), WSP(bf16, WS_V), WSP(bf16, WS_MQ), WSP(bf16, WS_MK), WSP(bf16, WS_MV), WSP(bf16, WS_MO), WSP(float, WS_G),
                     F.out + O_KP, F.out + O_VP, F.out + O_KS, F.out + O_VS};
#if defined(P3_ONE_CALL)
        pg8::gemm_phase<pg8::EpiIn<0>, pg8::StaticOrder, AL, SP>(F.lds, g, S, E); SEAM(3);
#else
        {
            { pg8::OffsetOrder S2; S2.init(MP, 10, 4, F.G, vc, D);
              pg8::EpiIn<0, 2> E2{E.SS, E.rope, E.qg, E.kg, E.big, E.bfg, E.Q, E.K, E.V, E.MQ, E.MK, E.MV, E.MO, E.G, E.KoP, E.VoP, E.KoS, E.VoS};
              pg8::gemm_phase<pg8::EpiIn<0, 2>, pg8::OffsetOrder, AL, SP>(F.lds, g, S2, E2); }
            { pg8::OffsetOrder S1; S1.init(MP, 4, 0, F.G, vc, D);
              pg8::EpiIn<0, 1> E1{E.SS, E.rope, E.qg, E.kg, E.big, E.bfg, E.Q, E.K, E.V, E.MQ, E.MK, E.MV, E.MO, E.G, E.KoP, E.VoP, E.KoS, E.VoS};
              pg8::gemm_phase<pg8::EpiIn<0, 1>, pg8::OffsetOrder, AL, SP>(F.lds, g, S1, E1); }
            { pg8::OffsetOrder S3; S3.init(MP, 1, 14, F.G, vc, D);
              pg8::EpiIn<0, 3> E3{E.SS, E.rope, E.qg, E.kg, E.big, E.bfg, E.Q, E.K, E.V, E.MQ, E.MK, E.MV, E.MO, E.G, E.KoP, E.VoP, E.KoS, E.VoS};
              pg8::gemm_phase<pg8::EpiIn<0, 3>, pg8::OffsetOrder, AL, SP>(F.lds, g, S3, E3); }
            SEAM(3); }
#endif
#if defined(NULL_PH3)
        { pg8::EpiNull EN; pg8::gemm_phase<pg8::EpiNull, pg8::StaticOrder, AL, SP>(F.lds, g, S, EN); SEAM(3); }
#endif
#if defined(VAR_PH3)
        { pg8::EpiIn<VAR_PH3> EV{E.SS, E.rope, E.qg, E.kg, E.big, E.bfg, E.Q, E.K, E.V, E.MQ, E.MK, E.MV, E.MO, E.G, E.KoP, E.VoP, E.KoS, E.VoS}; pg8::gemm_phase<pg8::EpiIn<VAR_PH3>, pg8::StaticOrder, AL, SP>(F.lds, g, S, EV); SEAM(3); }
#endif
#if REP_PH == 3 || REP_PH2 == 3
        pg8::gemm_phase<pg8::EpiIn<0>, pg8::StaticOrder, AL, SP>(F.lds, g, S, E); SEAM(3);
#endif
    }
    if (IN(4)) {
#ifndef REP_SUB
#define REP_SUB 0
#endif
#define MIX4A(qb) for (;;) { const int idx = queue_next(F, qb); if (idx >= U4_ML1) break; mlstm1_unit(F, idx); }
#define MIX4B(qb) for (;;) { const int idx = queue_next(F, qb + 64); if (idx >= U4_SATT) break; sattn_unit(F, idx); }
#define MIX4C(qb) for (;;) { const int idx = queue_next(F, qb + 128); if (idx >= U4_SML) break; smlstm_unit(F, idx); }
#define MIX4D(qb) for (;;) { const int idx = queue_next(F, qb + 192); if (idx >= U4_ATT) break; attn_seq_unit<false>(F, idx >> 4, (idx >> 1) & 7, idx & 1); }
#define MIX4(qb) MIX4A(qb) if (blockIdx.x & 1) { MIX4B(qb) MIX4C(qb) } MIX4D(qb) if (!(blockIdx.x & 1)) { MIX4B(qb) MIX4C(qb) }
#if REP_SUB == 1
        MIX4A(CW_Q4 + 2048) xcd_barrier(bar);
#elif REP_SUB == 2
        MIX4B(CW_Q4 + 2048) xcd_barrier(bar);
#elif REP_SUB == 3
        MIX4C(CW_Q4 + 2048) xcd_barrier(bar);
#elif REP_SUB == 4
        MIX4D(CW_Q4 + 2048) xcd_barrier(bar);
#elif REP_SUB == 41 || REP_SUB == 42 || REP_SUB == 44 || REP_SUB == 45
        for (;;) { const int idx = queue_next(F, CW_Q4 + 2048 + 192); if (idx >= U4_ATT) break; attn_seq_unit<false, REP_SUB - 40>(F, idx >> 4, (idx >> 1) & 7, idx & 1); } xcd_barrier(bar);
#endif
        {
            const int j = (int)blockIdx.x;
            if (j < N_SUNITS) {
                pg8::Gemm g{WSP(bf16, WS_XB), WSP(bf16, WS_WIN), MT, INP, D}; pg8::OneUnitOrder S1{256 + j / (INP / 256), j % (INP / 256), D / 64, true};
                pg8::EpiIn<0> E{WSP(float, WS_RS), WSP(float, WS_ROPE), F.in[13], F.in[14], F.in[15], F.in[16],
                             WSP(bf16, WS_Q), WSP(bf16, WS_K), WSP(bf16, WS_V), WSP(bf16, WS_MQ), WSP(bf16, WS_MK), WSP(bf16, WS_MV), WSP(bf16, WS_MO), WSP(float, WS_G),
                             F.out + O_KP, F.out + O_VP, F.out + O_KS, F.out + O_VS};
                pg8::gemm_phase<pg8::EpiIn<0>, pg8::OneUnitOrder, AL, SP>(F.lds, g, S1, E);
                sample_publish(F);
            }
        }
        MIX4A(CW_Q4)
        {   bool early = false;
            if (blockIdx.x & 1) { early = sample_acquire(F, false); if (early) { MIX4B(CW_Q4) MIX4C(CW_Q4) } }
            MIX4D(CW_Q4)
            if (!early) { (void)sample_acquire(F, true); MIX4B(CW_Q4) MIX4C(CW_Q4) } }
#if REP_PH == 4 || REP_PH2 == 4
        xcd_barrier(bar); MIX4(CW_Q4 + 1024)
#endif
        SEAM(4);
    }
    if (IN(5)) {
#define MIX5A(qb) mlstm2_seq(F, (int)blockIdx.x, F.G, U5_ML2);
#define MIX5B(qb) for (int idx = (int)blockIdx.x; idx < U5_ATT; idx += F.G) attn_seq_unit<true>(F, idx >> 3, idx & 7, 2);
#define MIX5(qb) MIX5A(qb) MIX5B(qb)
#if REP_SUB == 5
        MIX5A(CW_Q5 + 2048) xcd_barrier(bar);
#elif REP_SUB == 6
        MIX5B(CW_Q5 + 2048) xcd_barrier(bar);
#elif REP_SUB == 63
        for (;;) { const int idx = queue_next(F, CW_Q5 + 2048 + 64); if (idx >= U5_ATT) break; attn_seq_unit<true, 3>(F, idx >> 3, idx & 7, 2); } xcd_barrier(bar);
#endif
        MIX5(CW_Q5)
#if REP_PH == 5 || REP_PH2 == 5
        xcd_barrier(bar); MIX5(CW_Q5 + 1024)
#endif
        SEAM(5);
    }
    if (IN(6)) {
        pg8::Gemm g{WSP(bf16, WS_MIX), WSP(bf16, WS_WOUT), MT, D, D}; pg8::TailSplitOrder S; S.init(D, F.G, vc, D, 4);
        typedef pg8::EpiResid<1> E_t; E_t E{nullptr, nullptr, nullptr, WSP(bf16, WS_XB), WSP(float, WS_SS), WSP(float, WS_SLAB), 1.0f, WSP(unsigned char, WS_X8)};
        pg8::gemm_phase<E_t, pg8::TailSplitOrder, AL, SP>(F.lds, g, S, E); xcd_barrier(bar); reduce_tail<1, 4>(F, 1.0f);
        SEAM(6);
    }
    if (IN(7)) {
        pg8::Gemm g{WSP(bf16, WS_X8), WSP(bf16, WS_WGU2), MT, NGU, D / 2}; pg8::StaticOrder S; S.init(MT, NGU, F.G, vc, D / 2);
        pg8::EpiGateUp<true> E{WSP(bf16, WS_ACT), WSP(float, WS_RS), 1.0f / 512.f};
        pg8::gemm_phase<pg8::EpiGateUp<true>, pg8::StaticOrder, AL, SP, true>(F.lds, g, S, E); SEAM(7);
#if REP_PH == 7 || REP_PH2 == 7
        pg8::gemm_phase<pg8::EpiGateUp<true>, pg8::StaticOrder, AL, SP, true>(F.lds, g, S, E); SEAM(7);
#endif
    }
    if (IN(8)) {
        pg8::Gemm g{WSP(bf16, WS_ACT), WSP(bf16, WS_WD2), MT, D, FF / 2}; pg8::TailSplitOrder S; S.init(D, F.G, vc, FF / 2, 4);
        typedef pg8::EpiResid<2> E_t; E_t E{nullptr, nullptr, F.out + O_Y, WSP(bf16, WS_XB), nullptr, WSP(float, WS_SLAB), 0.5f / 512.f, nullptr};
        pg8::gemm_phase<E_t, pg8::TailSplitOrder, AL, SP, true>(F.lds, g, S, E); xcd_barrier(bar); reduce_tail<2, 5>(F, 0.5f / 512.f);
    }
#undef IN
#undef SEAM
}

extern "C" void kernel_launch(void* const* d_in, const int* in_sizes, int n_in, void* d_out, int out_size, void* d_ws, size_t ws_size, hipStream_t stream) {
    static int grid = 0;
    if (grid == 0) {
        if (n_in != 23 || in_sizes[0] != MP * D || (size_t)out_size != O_END || ws_size < WS_END) {
            fprintf(stderr, "kernel_launch: unexpected shapes (n_in %d, in0 %d, out %d, ws %zu; need ws >= %zu); nothing launched\n", n_in, n_in > 0 ? in_sizes[0] : -1, out_size, ws_size, (size_t)WS_END); grid = -1; return; }
        int dev = 0, cus = 0, per_cu = 0;
        if (hipGetDevice(&dev) != hipSuccess || hipDeviceGetAttribute(&cus, hipDeviceAttributeMultiprocessorCount, dev) != hipSuccess) { fprintf(stderr, "kernel_launch: device query failed\n"); grid = -1; return; }
        if (hipFuncSetAttribute((const void*)hymba_fwd, hipFuncAttributeMaxDynamicSharedMemorySize, LDS_BYTES) != hipSuccess) { fprintf(stderr, "kernel_launch: hipFuncSetAttribute failed\n"); grid = -1; return; }
        if (hipOccupancyMaxActiveBlocksPerMultiprocessor(&per_cu, (const void*)hymba_fwd, NWAVES * 64, LDS_BYTES) != hipSuccess || per_cu < 1)
            fprintf(stderr, "kernel_launch: note: occupancy query reports %d workgroups per CU\n", per_cu);
        (void)hipGetLastError();
        grid = cus;
    }
    if (grid < 0) return;
    if (hipMemsetAsync((char*)d_ws + WS_CTL, 0, CTL_ZERO_BYTES, stream) != hipSuccess) { fprintf(stderr, "kernel_launch: memset failed\n"); return; }
    Args a{};
    for (int i = 0; i < 23; ++i) a.in[i] = (const float*)d_in[i];
    a.out = (float*)d_out; a.ws = (unsigned char*)d_ws;
#if MK_N_LAUNCHES == 1
    a.ph_lo = 0; a.ph_hi = N_PHASES;
    hipLaunchKernelGGL(hymba_fwd, dim3(grid), dim3(NWAVES * 64), LDS_BYTES, stream, a);
#else
    for (int p = 0; p < N_PHASES; ++p) { a.ph_lo = p; a.ph_hi = p + 1; hipLaunchKernelGGL(hymba_fwd, dim3(grid), dim3(NWAVES * 64), LDS_BYTES, stream, a); }
#endif
    const hipError_t le = hipPeekAtLastError();
    if (le != hipSuccess) fprintf(stderr, "kernel_launch: launch failed: %s\n", hipGetErrorName(le));
}
```
